# Optimizing an MI355X kernel written in HIP

```python
import math
import jax, jax.numpy as jnp
from jax import lax
import numpy as np

D_MODEL = 1024
BATCH = 2
SEQ = 8192
DEPTH = 4

BRANCH_W = D_MODEL // 4
D_MIX = 4 * BRANCH_W
HEAD_DIM = 64
EPS = 1e-6
RET_HEADS = BRANCH_W // HEAD_DIM
RET_CHUNK = 64
ROPE_BASE = 10000.0
DN_HEADS = 4
DN_DK = 64
DN_DV = BRANCH_W // DN_HEADS
DN_CONV = 4
DN_CHUNK = 64
DN_QKV = 2 * DN_HEADS * DN_DK + DN_HEADS * DN_DV
S5_GROUP = 16
S5_GROUPS = BRANCH_W // S5_GROUP
S5_STATE = 64
S5_DT_MIN = 1e-3
S5_DT_MAX = 1e-1
GLA_HEADS = 4
GLA_DK = 32
GLA_DV = BRANCH_W // GLA_HEADS
GLA_QK = GLA_HEADS * GLA_DK
GLA_GATE_RANK = 16
GLA_GATE_TAU = 16.0
GLA_CHUNK = 16

IN_SPLITS = [
    BRANCH_W, BRANCH_W, BRANCH_W, BRANCH_W,
    DN_QKV, DN_HEADS, DN_HEADS, BRANCH_W,
    BRANCH_W, BRANCH_W,
    GLA_QK, GLA_QK, BRANCH_W, GLA_GATE_RANK, BRANCH_W,
]
IN_COLS = sum(IN_SPLITS)

kernel_name = "hymba_style_ret_deltanet_s5_gla"

F32 = jnp.float32


def _rmsnorm(x, g):
    x32 = x.astype(F32)
    y = x32 * lax.rsqrt(jnp.mean(x32 * x32, axis=-1, keepdims=True) + EPS)
    return (y * g.astype(F32)).astype(x.dtype)


def _head_rmsnorm(o, g):
    return o * lax.rsqrt(jnp.mean(o * o, axis=-1, keepdims=True) + EPS) * g.astype(F32)


def _l2norm(t):
    return t * lax.rsqrt(jnp.sum(t * t, axis=-1, keepdims=True) + EPS)


def _split_cols(t, sizes):
    offs = np.cumsum(sizes)[:-1].tolist()
    return jnp.split(t, offs, axis=-1)


def _heads(t, n_heads):
    b, l, _ = t.shape
    return t.reshape(b, l, n_heads, -1).transpose(0, 2, 1, 3)


def _merge(o):
    b, h, l, d = o.shape
    return o.transpose(0, 2, 1, 3).reshape(b, l, h * d)


def _chunk(t, c):
    return t.reshape(t.shape[0], t.shape[1], t.shape[2] // c, c, *t.shape[3:])


def _rotary(t, pos):
    d = t.shape[-1]
    inv = ROPE_BASE ** (-jnp.arange(0, d, 2, dtype=F32) / d)
    ang = pos[:, None] * inv[None, :]
    cos, sin = jnp.cos(ang), jnp.sin(ang)
    t1, t2 = t[..., 0::2], t[..., 1::2]
    return jnp.stack([t1 * cos - t2 * sin, t1 * sin + t2 * cos], axis=-1).reshape(t.shape)


def _causal_conv(x, w):
    k, ch = w.shape
    return lax.conv_general_dilated(x, w[:, None, :], window_strides=(1,), padding=((k - 1, 0),),
                                    dimension_numbers=('NWC', 'WIO', 'NWC'), feature_group_count=ch)


def _retention(q, k, v):
    b, h, l, dk = q.shape
    dv = v.shape[-1]
    c = RET_CHUNK
    log_gamma = jnp.log(1.0 - 2.0 ** (-5.0 - jnp.arange(h, dtype=F32)))
    pos = jnp.arange(l, dtype=F32)
    q = _rotary(q, pos) * (dk ** -0.5)
    k = _rotary(k, pos)
    qc, kc, vc = _chunk(q, c), _chunk(k, c), _chunk(v, c)
    idx = jnp.arange(c, dtype=F32)
    diff = idx[:, None] - idx[None, :]
    causal = diff >= 0
    dmat = jnp.where(causal, jnp.exp(log_gamma[:, None, None] * jnp.where(causal, diff, 0.0)), 0.0)
    scores = jnp.einsum('bhnid,bhnjd->bhnij', qc, kc) * dmat[None, :, None]
    o_intra = jnp.einsum('bhnij,bhnje->bhnie', scores, vc)
    q_decay = jnp.exp(log_gamma[:, None] * (idx + 1.0))
    k_decay = jnp.exp(log_gamma[:, None] * (c - 1.0 - idx))
    chunk_decay = jnp.exp(log_gamma * c)
    kv = jnp.einsum('bhncd,bhnce->bhnde', kc * k_decay[None, :, None, :, None], vc)

    def step(state, kv_n):
        return state * chunk_decay[None, :, None, None] + kv_n, state

    _, r_prev = lax.scan(step, jnp.zeros((b, h, dk, dv), F32), jnp.moveaxis(kv, 2, 0))
    r_prev = jnp.moveaxis(r_prev, 0, 2)
    o_inter = jnp.einsum('bhncd,bhnde->bhnce', qc, r_prev) * q_decay[None, :, None, :, None]
    return (o_intra + o_inter).reshape(b, h, l, dv)


def _retention_branch(rq, rk, rv, gate, norm_g):
    o = _retention(_heads(rq, RET_HEADS), _heads(rk, RET_HEADS), _heads(rv, RET_HEADS))
    return _merge(_head_rmsnorm(o, norm_g)) * jax.nn.silu(gate)


def _gated_delta_rule(q, k, v, beta, g):
    b, h, l, dk = q.shape
    dv = v.shape[-1]
    c = DN_CHUNK
    q = _l2norm(q) * (dk ** -0.5)
    k = _l2norm(k)
    qc, kc, vc = _chunk(q, c), _chunk(k, c), _chunk(v, c)
    bc, gc = _chunk(beta, c), _chunk(g, c)
    gcum = jnp.cumsum(gc, axis=-1)
    tri = jnp.tril(jnp.ones((c, c), dtype=bool))
    strict = jnp.tril(jnp.ones((c, c), dtype=bool), -1)
    decay = jnp.exp(jnp.where(tri, gcum[..., :, None] - gcum[..., None, :], -jnp.inf))
    kb = kc * bc[..., None]
    a_mat = jnp.where(strict, jnp.einsum('bhnid,bhnjd->bhnij', kb, kc) * decay, 0.0)
    rhs = jnp.concatenate([vc * bc[..., None], kb * jnp.exp(gcum)[..., None]], axis=-1)
    sol = lax.linalg.triangular_solve(jnp.eye(c, dtype=F32) + a_mat, rhs, left_side=True, lower=True)
    u, w = sol[..., :dv], sol[..., dv:]
    attn = jnp.einsum('bhnid,bhnjd->bhnij', qc, kc) * decay
    qg = qc * jnp.exp(gcum)[..., None]
    kg = kc * jnp.exp(gcum[..., -1:] - gcum)[..., None]
    glast = jnp.exp(gcum[..., -1])

    def step(state, inp):
        u_n, w_n, attn_n, qg_n, kg_n, gl_n = inp
        v_new = u_n - jnp.einsum('bhcd,bhde->bhce', w_n, state)
        o = jnp.einsum('bhcd,bhde->bhce', qg_n, state) + jnp.einsum('bhij,bhje->bhie', attn_n, v_new)
        state = state * gl_n[..., None, None] + jnp.einsum('bhcd,bhce->bhde', kg_n, v_new)
        return state, o

    xs = tuple(jnp.moveaxis(t, 2, 0) for t in (u, w, attn, qg, kg, glast))
    _, o = lax.scan(step, jnp.zeros((b, h, dk, dv), F32), xs)
    return jnp.moveaxis(o, 0, 2).reshape(b, h, l, dv)


def _deltanet_branch(qkv, beta_in, a_in, gate, conv_w, a_log, dt_bias, norm_g):
    qkv = jax.nn.silu(_causal_conv(qkv, conv_w.astype(F32)))
    q, k, v = jnp.split(qkv, [DN_HEADS * DN_DK, 2 * DN_HEADS * DN_DK], axis=-1)
    q, k, v = _heads(q, DN_HEADS), _heads(k, DN_HEADS), _heads(v, DN_HEADS)
    beta = jax.nn.sigmoid(beta_in).transpose(0, 2, 1)
    g = (-jnp.exp(a_log.astype(F32)) * jax.nn.softplus(a_in + dt_bias.astype(F32))).transpose(0, 2, 1)
    o = _gated_delta_rule(q, k, v, beta, g)
    return _merge(_head_rmsnorm(o, norm_g)) * jax.nn.silu(gate)


def _s5(u, lam_re, lam_im, b_re, b_im, c_re, c_im, d, log_dt):
    bsz, l, _ = u.shape
    ug = u.reshape(bsz, l, S5_GROUPS, S5_GROUP)
    lam_re, lam_im = lam_re.astype(F32), lam_im.astype(F32)
    dt = jnp.exp(log_dt.astype(F32))[:, None]
    mag = jnp.exp(lam_re * dt)
    ang = lam_im * dt
    a_re, a_im = mag * jnp.cos(ang), mag * jnp.sin(ang)
    den = lam_re * lam_re + lam_im * lam_im
    nr, ni = a_re - 1.0, a_im
    coef_re = (nr * lam_re + ni * lam_im) / den
    coef_im = (ni * lam_re - nr * lam_im) / den
    b_re, b_im = b_re.astype(F32), b_im.astype(F32)
    bb_re = coef_re[..., None] * b_re - coef_im[..., None] * b_im
    bb_im = coef_re[..., None] * b_im + coef_im[..., None] * b_re
    x_re = jnp.einsum('gph,blgh->blgp', bb_re, ug)
    x_im = jnp.einsum('gph,blgh->blgp', bb_im, ug)
    a_re_f = jnp.broadcast_to(a_re, x_re.shape)
    a_im_f = jnp.broadcast_to(a_im, x_im.shape)

    def combine(left, right):
        a1r, a1i, b1r, b1i = left
        a2r, a2i, b2r, b2i = right
        return (a2r * a1r - a2i * a1i, a2r * a1i + a2i * a1r,
                a2r * b1r - a2i * b1i + b2r, a2r * b1i + a2i * b1r + b2i)

    _, _, s_re, s_im = lax.associative_scan(combine, (a_re_f, a_im_f, x_re, x_im), axis=1)
    y = (jnp.einsum('ghp,blgp->blgh', c_re.astype(F32), s_re)
         - jnp.einsum('ghp,blgp->blgh', c_im.astype(F32), s_im)
         + d.astype(F32) * ug)
    return y.reshape(bsz, l, -1)


def _s5_branch(u, gate, lam_re, lam_im, b_re, b_im, c_re, c_im, d, log_dt, w_glu, b_glu):
    y = jax.nn.gelu(_s5(u, lam_re, lam_im, b_re, b_im, c_re, c_im, d, log_dt))
    y = y * jax.nn.sigmoid(y @ w_glu.astype(F32) + b_glu.astype(F32))
    return y * jax.nn.silu(gate)


def _gla(q, k, v, gk):
    b, h, l, dk = q.shape
    dv = v.shape[-1]
    c = GLA_CHUNK
    q = q * (dk ** -0.5)
    qc, kc, vc, gc = _chunk(q, c), _chunk(k, c), _chunk(v, c), _chunk(gk, c)
    cum = jnp.cumsum(gc, axis=3)
    causal = jnp.tril(jnp.ones((c, c), dtype=bool))
    rel = cum[:, :, :, :, None, :] - cum[:, :, :, None, :, :]
    rel = jnp.where(causal[:, :, None], rel, -jnp.inf)
    scores = jnp.sum(qc[:, :, :, :, None, :] * kc[:, :, :, None, :, :] * jnp.exp(rel), axis=-1)
    o_intra = jnp.einsum('bhnij,bhnje->bhnie', scores, vc)
    cum_last = cum[:, :, :, -1]
    kv = jnp.einsum('bhncd,bhnce->bhnde', kc * jnp.exp(cum_last[:, :, :, None] - cum), vc)

    def step(state, inp):
        kv_n, dec_n = inp
        return state * dec_n[..., None] + kv_n, state

    _, s_prev = lax.scan(step, jnp.zeros((b, h, dk, dv), F32),
                         (jnp.moveaxis(kv, 2, 0), jnp.moveaxis(jnp.exp(cum_last), 2, 0)))
    s_prev = jnp.moveaxis(s_prev, 0, 2)
    o_inter = jnp.einsum('bhncd,bhnde->bhnce', qc * jnp.exp(cum), s_prev)
    return (o_intra + o_inter).reshape(b, h, l, dv)


def _gla_branch(q, k, v, gate_code, gate, w_gk, b_gk, norm_g):
    gk = jax.nn.log_sigmoid(gate_code @ w_gk.astype(F32) + b_gk.astype(F32)) / GLA_GATE_TAU
    o = _gla(_heads(q, GLA_HEADS), _heads(k, GLA_HEADS), _heads(v, GLA_HEADS), _heads(gk, GLA_HEADS))
    return _merge(_head_rmsnorm(o, norm_g)) * jax.nn.silu(gate)


def setup_inputs(seed: int = 0) -> dict:
    key = jax.random.key(seed)
    ks = jax.random.split(key, 24)

    def nrm(k, shape, scale):
        return jax.random.normal(k, shape, F32) * scale

    x = nrm(ks[0], (BATCH, SEQ, D_MODEL), 1.0)
    norm_pre = 1.0 + nrm(ks[1], (DEPTH, D_MODEL), 0.02)
    norm_post = 1.0 + nrm(ks[2], (DEPTH, D_MODEL), 0.02)
    w_in = nrm(ks[3], (DEPTH, D_MODEL, IN_COLS), D_MODEL ** -0.5)
    w_out = nrm(ks[4], (DEPTH, D_MIX, D_MODEL), D_MIX ** -0.5)
    ret_norm = 1.0 + nrm(ks[5], (DEPTH, HEAD_DIM), 0.02)
    dn_conv = nrm(ks[6], (DEPTH, DN_CONV, DN_QKV), DN_CONV ** -0.5)
    dn_a_log = jnp.log(jax.random.uniform(ks[7], (DEPTH, DN_HEADS), F32, 1.0, 16.0))
    dt = jnp.exp(jax.random.uniform(ks[8], (DEPTH, DN_HEADS), F32, math.log(1e-3), math.log(1e-1)))
    dn_dt_bias = dt + jnp.log(-jnp.expm1(-dt))
    dn_norm = 1.0 + nrm(ks[9], (DEPTH, DN_DV), 0.02)
    n_idx = jnp.arange(S5_STATE, dtype=F32)
    s5_lam_re = -0.5 + nrm(ks[10], (DEPTH, S5_GROUPS, S5_STATE), 0.01)
    s5_lam_im = math.pi * n_idx + nrm(ks[11], (DEPTH, S5_GROUPS, S5_STATE), 0.01)
    s5_b_re = nrm(ks[12], (DEPTH, S5_GROUPS, S5_STATE, S5_GROUP), (2 * S5_GROUP) ** -0.5)
    s5_b_im = nrm(ks[13], (DEPTH, S5_GROUPS, S5_STATE, S5_GROUP), (2 * S5_GROUP) ** -0.5)
    s5_c_re = nrm(ks[14], (DEPTH, S5_GROUPS, S5_GROUP, S5_STATE), S5_STATE ** -0.5)
    s5_c_im = nrm(ks[15], (DEPTH, S5_GROUPS, S5_GROUP, S5_STATE), S5_STATE ** -0.5)
    s5_d = nrm(ks[16], (DEPTH, S5_GROUPS, S5_GROUP), 1.0)
    s5_log_dt = jax.random.uniform(ks[17], (DEPTH, S5_GROUPS), F32, math.log(S5_DT_MIN), math.log(S5_DT_MAX))
    s5_w_glu = nrm(ks[18], (DEPTH, BRANCH_W, BRANCH_W), BRANCH_W ** -0.5)
    s5_b_glu = nrm(ks[19], (DEPTH, BRANCH_W), 0.01)
    gla_w_gk = nrm(ks[20], (DEPTH, GLA_GATE_RANK, GLA_QK), GLA_GATE_RANK ** -0.5)
    gla_b_gk = nrm(ks[21], (DEPTH, GLA_QK), 0.01)
    gla_norm = 1.0 + nrm(ks[22], (DEPTH, GLA_DV), 0.02)
    return {"x": x, "norm_pre": norm_pre, "norm_post": norm_post, "w_in": w_in, "w_out": w_out,
            "ret_norm": ret_norm, "dn_conv": dn_conv, "dn_a_log": dn_a_log, "dn_dt_bias": dn_dt_bias,
            "dn_norm": dn_norm, "s5_lam_re": s5_lam_re, "s5_lam_im": s5_lam_im, "s5_b_re": s5_b_re,
            "s5_b_im": s5_b_im, "s5_c_re": s5_c_re, "s5_c_im": s5_c_im, "s5_d": s5_d,
            "s5_log_dt": s5_log_dt, "s5_w_glu": s5_w_glu, "s5_b_glu": s5_b_glu,
            "gla_w_gk": gla_w_gk, "gla_b_gk": gla_b_gk, "gla_norm": gla_norm}


def reference(x, norm_pre, norm_post, w_in, w_out, ret_norm, dn_conv, dn_a_log, dn_dt_bias, dn_norm,
              s5_lam_re, s5_lam_im, s5_b_re, s5_b_im, s5_c_re, s5_c_im, s5_d, s5_log_dt, s5_w_glu, s5_b_glu,
              gla_w_gk, gla_b_gk, gla_norm):
    for i in range(DEPTH):
        h = _rmsnorm(x, norm_pre[i])
        p = jnp.einsum('bld,dc->blc', h, w_in[i]).astype(F32)
        (rq, rk, rv, rg, dqkv, dbeta, da, dg, su, sg, gq, gkk, gv, gcode, gg) = _split_cols(p, IN_SPLITS)
        y_ret = _retention_branch(rq, rk, rv, rg, ret_norm[i])
        y_dn = _deltanet_branch(dqkv, dbeta, da, dg, dn_conv[i], dn_a_log[i], dn_dt_bias[i], dn_norm[i])
        y_s5 = _s5_branch(su, sg, s5_lam_re[i], s5_lam_im[i], s5_b_re[i], s5_b_im[i], s5_c_re[i], s5_c_im[i],
                          s5_d[i], s5_log_dt[i], s5_w_glu[i], s5_b_glu[i])
        y_gla = _gla_branch(gq, gkk, gv, gcode, gg, gla_w_gk[i], gla_b_gk[i], gla_norm[i])
        y = jnp.concatenate([y_ret, y_dn, y_s5, y_gla], axis=-1).astype(x.dtype)
        o = jnp.einsum('blm,md->bld', y, w_out[i])
        x = x + _rmsnorm(o, norm_post[i])
    return x
```

```cpp
#include <hip/hip_runtime.h>
#include <math.h>

namespace {
constexpr int D = 1024, NB = 2, L = 8192, DEPTH = 4, NC = 3352;
constexpr int C_RQ = 0, C_RK = 256, C_RV = 512, C_RG = 768, C_DQKV = 1024, C_DBETA = 1792, C_DA = 1796, C_DG = 1800,
              C_SU = 2056, C_SG = 2312, C_GQ = 2568, C_GK = 2696, C_GV = 2824, C_GCODE = 3080, C_GG = 3096;
constexpr float EPS = 1e-6f;

__device__ __forceinline__ float wave_sum(float v) {
#pragma unroll
    for (int o = 1; o < 64; o <<= 1) v += __shfl_xor(v, o);
    return v;
}
__device__ __forceinline__ float sigmoidf_(float x) { return 1.f / (1.f + expf(-x)); }
__device__ __forceinline__ float siluf_(float x) { return x * sigmoidf_(x); }
__device__ __forceinline__ float softplusf_(float x) { return fmaxf(x, 0.f) + log1pf(expf(-fabsf(x))); }
__device__ __forceinline__ float geluf_(float x) { return 0.5f * x * (1.f + tanhf(0.7978845608028654f * (x + 0.044715f * x * x * x))); }

__global__ void k_rstd(const float* __restrict__ x, float* __restrict__ rstd, int rows) {
    const int row = blockIdx.x * 4 + (threadIdx.x >> 6), lane = threadIdx.x & 63;
    if (row >= rows) return;
    const float* xr = x + (size_t)row * D;
    float s = 0.f;
    for (int c = lane; c < D; c += 64) s += xr[c] * xr[c];
    s = wave_sum(s);
    if (lane == 0) rstd[row] = rsqrtf(s / D + EPS);
}
__global__ void __launch_bounds__(256) k_gemm(const float* __restrict__ A, int lda, const float* __restrict__ rs, const float* __restrict__ cs,
                                               const float* __restrict__ Bm, int ldb, float* __restrict__ C, int ldc, int M, int N, int K) {
    __shared__ float sA[16][64 + 4], sB[16][64 + 4];
    const int tx = threadIdx.x & 15, ty = threadIdx.x >> 4;
    const int m0 = blockIdx.y * 64, n0 = blockIdx.x * 64;
    float acc[4][4] = {};
    for (int k0 = 0; k0 < K; k0 += 16) {
        for (int e = threadIdx.x; e < 64 * 16; e += 256) {
            const int m = e >> 4, k = e & 15;
            float a = A[(size_t)(m0 + m) * lda + k0 + k];
            if (rs) a *= rs[m0 + m];
            if (cs) a *= cs[k0 + k];
            sA[k][m] = a;
        }
        for (int e = threadIdx.x; e < 64 * 16; e += 256) {
            const int k = e >> 6, n = e & 63;
            sB[k][n] = (n0 + n < N) ? Bm[(size_t)(k0 + k) * ldb + n0 + n] : 0.f;
        }
        __syncthreads();
#pragma unroll
        for (int k = 0; k < 16; ++k) {
            float a[4], b[4];
#pragma unroll
            for (int i = 0; i < 4; ++i) { a[i] = sA[k][ty * 4 + i]; b[i] = sB[k][tx * 4 + i]; }
#pragma unroll
            for (int i = 0; i < 4; ++i)
#pragma unroll
                for (int j = 0; j < 4; ++j) acc[i][j] += a[i] * b[j];
        }
        __syncthreads();
    }
#pragma unroll
    for (int i = 0; i < 4; ++i)
#pragma unroll
        for (int j = 0; j < 4; ++j) {
            const int m = m0 + ty * 4 + i, n = n0 + tx * 4 + j;
            if (n < N) C[(size_t)m * ldc + n] = acc[i][j];
        }
}
__global__ void k_resnorm(float* __restrict__ x, const float* __restrict__ o, const float* __restrict__ g, int rows) {
    const int row = blockIdx.x * 4 + (threadIdx.x >> 6), lane = threadIdx.x & 63;
    if (row >= rows) return;
    const float* orow = o + (size_t)row * D;
    float* xr = x + (size_t)row * D;
    float s = 0.f;
    for (int c = lane; c < D; c += 64) s += orow[c] * orow[c];
    s = wave_sum(s);
    const float r = rsqrtf(s / D + EPS);
    for (int c = lane; c < D; c += 64) xr[c] += orow[c] * r * g[c];
}

__global__ void __launch_bounds__(64) k_ret(const float* __restrict__ p, const float* __restrict__ norm_g, float* __restrict__ y) {
    __shared__ float sq[64], sk[64];
    const int h = blockIdx.x, lane = threadIdx.x;
    const float gamma = 1.f - exp2f(-5.f - (float)h);
    const float inv = powf(10000.f, -(float)(2 * (lane >> 1)) / 64.f);
    float S[64];
#pragma unroll
    for (int d = 0; d < 64; ++d) S[d] = 0.f;
    const float gn = norm_g[lane];
    for (int t = 0; t < L; ++t) {
        const float* pr = p + (size_t)t * NC;
        const float q = pr[C_RQ + h * 64 + lane], k = pr[C_RK + h * 64 + lane], v = pr[C_RV + h * 64 + lane], gate = pr[C_RG + h * 64 + lane];
        float sn, cs; sincosf((float)t * inv, &sn, &cs);
        const float qo = __shfl_xor(q, 1), ko = __shfl_xor(k, 1);
        const float qr = (lane & 1) ? (qo * sn + q * cs) : (q * cs - qo * sn);
        const float kr = (lane & 1) ? (ko * sn + k * cs) : (k * cs - ko * sn);
        __syncthreads();
        sq[lane] = qr * 0.125f; sk[lane] = kr;
        __syncthreads();
        float o = 0.f;
#pragma unroll
        for (int d = 0; d < 64; ++d) { S[d] = gamma * S[d] + sk[d] * v; o += sq[d] * S[d]; }
        const float ms = wave_sum(o * o) * (1.f / 64.f);
        y[(size_t)t * D + 0 + h * 64 + lane] = o * rsqrtf(ms + EPS) * gn * siluf_(gate);
    }
}

__global__ void k_dn_conv(const float* __restrict__ p, const float* __restrict__ cw  , float* __restrict__ qkv) {
    const size_t idx = (size_t)blockIdx.x * 256 + threadIdx.x;
    if (idx >= (size_t)L * 768) return;
    const int t = (int)(idx / 768), c = (int)(idx % 768);
    float a = 0.f;
#pragma unroll
    for (int j = 0; j < 4; ++j) { const int tt = t - 3 + j; if (tt >= 0) a += cw[j * 768 + c] * p[(size_t)tt * NC + C_DQKV + c]; }
    qkv[idx] = siluf_(a);
}
__global__ void __launch_bounds__(64) k_dn_rec(const float* __restrict__ p, const float* __restrict__ qkv, const float* __restrict__ a_log, const float* __restrict__ dt_bias,
                                                const float* __restrict__ norm_g, float* __restrict__ y) {
    __shared__ float sq[64], sk[64];
    const int h = blockIdx.x, lane = threadIdx.x;
    float S[64];
#pragma unroll
    for (int d = 0; d < 64; ++d) S[d] = 0.f;
    const float gn = norm_g[lane], A = -expf(a_log[h]), dtb = dt_bias[h];
    for (int t = 0; t < L; ++t) {
        const float* pr = p + (size_t)t * NC;
        const float* cr = qkv + (size_t)t * 768;
        float q = cr[h * 64 + lane], k = cr[256 + h * 64 + lane];
        const float v = cr[512 + h * 64 + lane], gate = pr[C_DG + h * 64 + lane];
        q = q * rsqrtf(wave_sum(q * q) + EPS) * 0.125f;
        k = k * rsqrtf(wave_sum(k * k) + EPS);
        const float beta = sigmoidf_(pr[C_DBETA + h]);
        const float eg = expf(A * softplusf_(pr[C_DA + h] + dtb));
        __syncthreads();
        sq[lane] = q; sk[lane] = k;
        __syncthreads();
        float ks = 0.f;
#pragma unroll
        for (int d = 0; d < 64; ++d) { S[d] *= eg; ks += sk[d] * S[d]; }
        const float vn = beta * (v - ks);
        float o = 0.f;
#pragma unroll
        for (int d = 0; d < 64; ++d) { S[d] += sk[d] * vn; o += sq[d] * S[d]; }
        const float ms = wave_sum(o * o) * (1.f / 64.f);
        y[(size_t)t * D + 256 + h * 64 + lane] = o * rsqrtf(ms + EPS) * gn * siluf_(gate);
    }
}

__global__ void k_s5_coef(const float* __restrict__ lam_re, const float* __restrict__ lam_im, const float* __restrict__ b_re, const float* __restrict__ b_im,
                          const float* __restrict__ log_dt, float* __restrict__ coef  ) {
    const int i = blockIdx.x * 256 + threadIdx.x;
    if (i >= 1024) return;
    const int g = i >> 6;
    const float dt = expf(log_dt[g]);
    const float lr = lam_re[i], li = lam_im[i];
    const float mag = expf(lr * dt), ang = li * dt;
    const float ar = mag * cosf(ang), ai = mag * sinf(ang);
    const float den = lr * lr + li * li, nr = ar - 1.f, ni = ai;
    const float cr = (nr * lr + ni * li) / den, ci = (ni * lr - nr * li) / den;
    coef[i] = ar; coef[1024 + i] = ai;
    for (int h = 0; h < 16; ++h) {
        const float br = b_re[i * 16 + h], bi = b_im[i * 16 + h];
        coef[2048 + i * 16 + h] = cr * br - ci * bi;
        coef[2048 + 16384 + i * 16 + h] = cr * bi + ci * br;
    }
}
__global__ void __launch_bounds__(64) k_s5_scan(const float* __restrict__ p, const float* __restrict__ coef, float* __restrict__ Sre, float* __restrict__ Sim) {
    const int i = blockIdx.x * 64 + threadIdx.x;
    const int g = i >> 6;
    const float ar = coef[i], ai = coef[1024 + i];
    float br[16], bi[16];
#pragma unroll
    for (int h = 0; h < 16; ++h) { br[h] = coef[2048 + i * 16 + h]; bi[h] = coef[2048 + 16384 + i * 16 + h]; }
    float sr = 0.f, si = 0.f;
    for (int t = 0; t < L; ++t) {
        const float* u = p + (size_t)t * NC + C_SU + g * 16;
        float xr = 0.f, xi = 0.f;
#pragma unroll
        for (int h = 0; h < 16; ++h) { const float uu = u[h]; xr += br[h] * uu; xi += bi[h] * uu; }
        const float nr = ar * sr - ai * si + xr, ni = ar * si + ai * sr + xi;
        sr = nr; si = ni;
        Sre[(size_t)t * 1024 + i] = sr; Sim[(size_t)t * 1024 + i] = si;
    }
}
__global__ void k_s5_out(const float* __restrict__ p, const float* __restrict__ Sre, const float* __restrict__ Sim, const float* __restrict__ c_re, const float* __restrict__ c_im,
                         const float* __restrict__ dd, float* __restrict__ yg) {
    const size_t idx = (size_t)blockIdx.x * 256 + threadIdx.x;
    const int t = (int)(idx >> 8), c = (int)(idx & 255), g = c >> 4;
    const float* sr = Sre + (size_t)t * 1024 + g * 64;
    const float* si = Sim + (size_t)t * 1024 + g * 64;
    const float* cr = c_re + c * 64;
    const float* ci = c_im + c * 64;
    float a = 0.f;
    for (int q = 0; q < 64; ++q) a += cr[q] * sr[q] - ci[q] * si[q];
    a += dd[c] * p[(size_t)t * NC + C_SU + c];
    yg[idx] = geluf_(a);
}
__global__ void k_s5_glu(const float* __restrict__ p, const float* __restrict__ yg, const float* __restrict__ w_glu, const float* __restrict__ b_glu, float* __restrict__ y) {
    const size_t idx = (size_t)blockIdx.x * 256 + threadIdx.x;
    const int t = (int)(idx >> 8), c = (int)(idx & 255);
    const float* yr = yg + (size_t)t * 256;
    float z = b_glu[c];
    for (int k = 0; k < 256; ++k) z += yr[k] * w_glu[k * 256 + c];
    y[(size_t)t * D + 512 + c] = yr[c] * sigmoidf_(z) * siluf_(p[(size_t)t * NC + C_SG + c]);
}

__global__ void k_gla_gk(const float* __restrict__ p, const float* __restrict__ w_gk, const float* __restrict__ b_gk, float* __restrict__ gk) {
    const size_t idx = (size_t)blockIdx.x * 256 + threadIdx.x;
    const int t = (int)(idx >> 7), j = (int)(idx & 127);
    const float* gc = p + (size_t)t * NC + C_GCODE;
    float z = b_gk[j];
#pragma unroll
    for (int r = 0; r < 16; ++r) z += gc[r] * w_gk[r * 128 + j];
    gk[idx] = -softplusf_(-z) * (1.f / 16.f);
}
__global__ void __launch_bounds__(64) k_gla_rec(const float* __restrict__ p, const float* __restrict__ gk, const float* __restrict__ norm_g, float* __restrict__ y) {
    const int h = blockIdx.x, lane = threadIdx.x;
    float S[32];
#pragma unroll
    for (int d = 0; d < 32; ++d) S[d] = 0.f;
    const float gn = norm_g[lane];
    const float qs = 0.17677669529663687f;
    for (int t = 0; t < L; ++t) {
        const float* pr = p + (size_t)t * NC;
        const float* q = pr + C_GQ + h * 32;
        const float* k = pr + C_GK + h * 32;
        const float* g = gk + (size_t)t * 128 + h * 32;
        const float v = pr[C_GV + h * 64 + lane], gate = pr[C_GG + h * 64 + lane];
        float o = 0.f;
#pragma unroll
        for (int d = 0; d < 32; ++d) { S[d] = expf(g[d]) * S[d] + k[d] * v; o += q[d] * S[d]; }
        o *= qs;
        const float ms = wave_sum(o * o) * (1.f / 64.f);
        y[(size_t)t * D + 768 + h * 64 + lane] = o * rsqrtf(ms + EPS) * gn * siluf_(gate);
    }
}
}

extern "C" void kernel_launch(void* const* d_in, const int* in_sizes, int n_in, void* d_out, int out_size, void* d_ws, size_t ws_size, hipStream_t stream) {
    const float* x_in = (const float*)d_in[0];
    const float* norm_pre = (const float*)d_in[1];
    const float* norm_post = (const float*)d_in[2];
    const float* w_in = (const float*)d_in[3];
    const float* w_out = (const float*)d_in[4];
    const float* ret_norm = (const float*)d_in[5];
    const float* dn_conv = (const float*)d_in[6];
    const float* dn_a_log = (const float*)d_in[7];
    const float* dn_dt_bias = (const float*)d_in[8];
    const float* dn_norm = (const float*)d_in[9];
    const float* s5_lam_re = (const float*)d_in[10];
    const float* s5_lam_im = (const float*)d_in[11];
    const float* s5_b_re = (const float*)d_in[12];
    const float* s5_b_im = (const float*)d_in[13];
    const float* s5_c_re = (const float*)d_in[14];
    const float* s5_c_im = (const float*)d_in[15];
    const float* s5_d = (const float*)d_in[16];
    const float* s5_log_dt = (const float*)d_in[17];
    const float* s5_w_glu = (const float*)d_in[18];
    const float* s5_b_glu = (const float*)d_in[19];
    const float* gla_w_gk = (const float*)d_in[20];
    const float* gla_b_gk = (const float*)d_in[21];
    const float* gla_norm = (const float*)d_in[22];
    float* xc = (float*)d_out;
    float* ws = (float*)d_ws;
    float* P = ws;
    float* Y = P + (size_t)L * NC;
    float* QKV = Y + (size_t)L * D;
    float* GK = QKV + (size_t)L * 768;
    float* SRE = GK + (size_t)L * 128;
    float* SIM = SRE + (size_t)L * 1024;
    float* YG = SIM + (size_t)L * 1024;
    float* RSTD = YG + (size_t)L * 256;
    float* COEF = RSTD + L;

    hipMemcpyAsync(xc, x_in, sizeof(float) * (size_t)NB * L * D, hipMemcpyDeviceToDevice, stream);
    for (int i = 0; i < DEPTH; ++i) {
        k_s5_coef<<<4, 256, 0, stream>>>(s5_lam_re + i * 1024, s5_lam_im + i * 1024, s5_b_re + i * 16384, s5_b_im + i * 16384, s5_log_dt + i * 16, COEF);
        for (int b = 0; b < NB; ++b) {
            float* xb = xc + (size_t)b * L * D;
            k_rstd<<<L / 4, 256, 0, stream>>>(xb, RSTD, L);
            k_gemm<<<dim3((NC + 63) / 64, L / 64), 256, 0, stream>>>(xb, D, RSTD, norm_pre + i * D, w_in + (size_t)i * D * NC, NC, P, NC, L, NC, D);
            k_ret<<<4, 64, 0, stream>>>(P, ret_norm + i * 64, Y);
            k_dn_conv<<<(L * 768 + 255) / 256, 256, 0, stream>>>(P, dn_conv + i * 4 * 768, QKV);
            k_dn_rec<<<4, 64, 0, stream>>>(P, QKV, dn_a_log + i * 4, dn_dt_bias + i * 4, dn_norm + i * 64, Y);
            k_s5_scan<<<16, 64, 0, stream>>>(P, COEF, SRE, SIM);
            k_s5_out<<<L, 256, 0, stream>>>(P, SRE, SIM, s5_c_re + i * 16384, s5_c_im + i * 16384, s5_d + i * 256, YG);
            k_s5_glu<<<L, 256, 0, stream>>>(P, YG, s5_w_glu + i * 65536, s5_b_glu + i * 256, Y);
            k_gla_gk<<<L * 128 / 256, 256, 0, stream>>>(P, gla_w_gk + i * 16 * 128, gla_b_gk + i * 128, GK);
            k_gla_rec<<<4, 64, 0, stream>>>(P, GK, gla_norm + i * 64, Y);
            k_gemm<<<dim3(D / 64, L / 64), 256, 0, stream>>>(Y, D, nullptr, nullptr, w_out + (size_t)i * D * D, D, P, D, L, D, D);
            k_resnorm<<<L / 4, 256, 0, stream>>>(xb, P, norm_post + i * D, L);
        }
    }
}
```

```cpp
#include <hip/hip_runtime.h>
#include <cstdio>
#include <cstdint>
#include <math.h>
namespace pg8 {
#define PG8_LAS __attribute__((address_space(3)))
typedef unsigned short bf16_t;
typedef short bf16x8 __attribute__((ext_vector_type(8)));
typedef float f32x4 __attribute__((ext_vector_type(4)));
typedef unsigned u32x4 __attribute__((ext_vector_type(4)));
constexpr int BM = 256, BK = 64, HALF = 128, HTB = HALF * BK * 2  , STAGE_BYTES = 8 * HTB, NXCD = 8, WGM = 8;

__host__ __device__ __forceinline__ int lds_byte(int r, int c) { const int st = (r >> 4) * 2 + (c >> 5), rr = r & 15, cc = c & 31, ob = rr * 64 + cc * 2; return st * 1024 + (ob ^ (((ob >> 9) & 1) << 5)); }
__host__ __device__ __forceinline__ void stage_rc(int b, int& R, int& C) { const int st = b / 1024, sb = b % 1024, swz = sb ^ (((sb >> 9) & 1) << 5); R = (st >> 1) * 16 + swz / 64; C = (st & 1) * 32 + (swz % 64) / 2; }
__host__ __device__ __forceinline__ int perm32(int rho) { const int n = rho >> 4, i = rho & 15; return 8 * (i >> 2) + 4 * n + (i & 3); }

struct Unit { int pm, pn; };
struct Gemm { const bf16_t* A; const bf16_t* Bt; int M, N, K, lda, ldb; };

struct StaticOrder {
    int nM, nN, nwg, G, c;
    __host__ __device__ void init(int M, int N, int G_, int c_) { nM = M / BM; nN = N / BM; nwg = nM * nN; G = G_; c = c_; }
    __host__ __device__ bool next(int i, Unit& u) const {
        const long L = (long)i * G + c; if (L >= nwg) return false;
        int wgid = (int)L; { const int q = nwg / NXCD, r = nwg % NXCD, xcd = wgid % NXCD, off = wgid / NXCD; wgid = (xcd < r ? xcd * (q + 1) : r * (q + 1) + (xcd - r) * q) + off; }
        const int nig = WGM * nN, gid = wgid / nig, fm = gid * WGM, gsz = (nM - fm) < WGM ? (nM - fm) : WGM;
        u.pm = fm + ((wgid % nig) % gsz); u.pn = (wgid % nig) / gsz; return true;
    }
    __device__ __forceinline__ void a_ready(const Unit&) const {}
    __device__ __forceinline__ void done(const Unit&) const {}
};

__device__ __forceinline__ unsigned cvt_pk_bf16(float lo, float hi) { unsigned r; asm volatile("v_cvt_pk_bf16_f32 %0, %1, %2" : "=v"(r) : "v"(lo), "v"(hi)); return r; }
__device__ __forceinline__ float bf_lo(unsigned w) { return __builtin_bit_cast(float, w << 16); }
__device__ __forceinline__ float bf_hi(unsigned w) { return __builtin_bit_cast(float, w & 0xffff0000u); }
struct EpiStoreBf16 {
    static constexpr bool PERM = true, AFTER_DRAIN = false;
    bf16_t* O; int ldc;
    __device__ __forceinline__ void operator()(const f32x4 (&acc)[2][2][4][2], const Unit& u, int wr, int wc, int fr, int fq) const {
        const int row0 = u.pm * BM + wr * 64 + fr, col0 = u.pn * BM + wc * 32 + 8 * fq;
#pragma unroll
        for (int ai = 0; ai < 2; ++ai)
#pragma unroll
            for (int m = 0; m < 4; ++m) { bf16_t* rowp = O + (size_t)(row0 + ai * HALF + m * 16) * ldc + col0;
#pragma unroll
                for (int bj = 0; bj < 2; ++bj) { const f32x4 v0 = acc[ai][bj][m][0], v1 = acc[ai][bj][m][1];
                    u32x4 w; w.x = cvt_pk_bf16(v0[0], v0[1]); w.y = cvt_pk_bf16(v0[2], v0[3]); w.z = cvt_pk_bf16(v1[0], v1[1]); w.w = cvt_pk_bf16(v1[2], v1[3]);
                    *(u32x4*)(rowp + bj * HALF) = w; } }
    }
};
struct EpiStoreF32 {
    static constexpr bool PERM = false, AFTER_DRAIN = false;
    float* C; int ldc;
    __device__ __forceinline__ void operator()(const f32x4 (&acc)[2][2][4][2], const Unit& u, int wr, int wc, int fr, int fq) const {
        const int row0 = u.pm * BM + wr * 64 + fr, col0 = u.pn * BM + wc * 32 + 4 * fq;
#pragma unroll
        for (int ai = 0; ai < 2; ++ai)
#pragma unroll
            for (int m = 0; m < 4; ++m) { float* rowp = C + (size_t)(row0 + ai * HALF + m * 16) * ldc + col0;
#pragma unroll
                for (int bj = 0; bj < 2; ++bj)
#pragma unroll
                    for (int n = 0; n < 2; ++n) *(f32x4*)(rowp + bj * HALF + n * 16) = acc[ai][bj][m][n]; }
    }
};
struct EpiGlu {
    static constexpr bool PERM = true, AFTER_DRAIN = false;
    const bf16_t* YG; const bf16_t* SG; int ldp; const float* bias; bf16_t* O; int ldo;
    __device__ __forceinline__ void operator()(const f32x4 (&acc)[2][2][4][2], const Unit& u, int wr, int wc, int fr, int fq) const {
        const int row0 = u.pm * BM + wr * 64 + fr, col0 = u.pn * BM + wc * 32 + 8 * fq;
#pragma unroll
        for (int ai = 0; ai < 2; ++ai)
#pragma unroll
            for (int m = 0; m < 4; ++m) { const size_t r = (size_t)(row0 + ai * HALF + m * 16);
#pragma unroll
                for (int bj = 0; bj < 2; ++bj) { const int c = col0 + bj * HALF;
                    const u32x4 yw = *(const u32x4*)(YG + r * ldp + c), gw = *(const u32x4*)(SG + r * ldp + c);
                    const f32x4 b0 = *(const f32x4*)(bias + c), b1 = *(const f32x4*)(bias + c + 4);
                    const f32x4 v0 = acc[ai][bj][m][0] + b0, v1 = acc[ai][bj][m][1] + b1;
                    float z[8] = {v0[0], v0[1], v0[2], v0[3], v1[0], v1[1], v1[2], v1[3]};
                    float yv[8] = {bf_lo(yw.x), bf_hi(yw.x), bf_lo(yw.y), bf_hi(yw.y), bf_lo(yw.z), bf_hi(yw.z), bf_lo(yw.w), bf_hi(yw.w)};
                    float gv[8] = {bf_lo(gw.x), bf_hi(gw.x), bf_lo(gw.y), bf_hi(gw.y), bf_lo(gw.z), bf_hi(gw.z), bf_lo(gw.w), bf_hi(gw.w)};
                    float o[8];
#pragma unroll
                    for (int e = 0; e < 8; ++e) { const float sz = 1.f / (1.f + __expf(-z[e])), sg = gv[e] / (1.f + __expf(-gv[e])); o[e] = yv[e] * sz * sg; }
                    u32x4 w; w.x = cvt_pk_bf16(o[0], o[1]); w.y = cvt_pk_bf16(o[2], o[3]); w.z = cvt_pk_bf16(o[4], o[5]); w.w = cvt_pk_bf16(o[6], o[7]);
                    *(u32x4*)(O + r * ldo + c) = w; } }
    }
};

template <class Epi, class Sched, bool ALIGN_EPI, bool SP2, int KK, int LDA, int LDB>
__device__ __forceinline__ void gemm_phase(PG8_LAS unsigned char* lds, const Gemm g, const Sched& S, const Epi& E) {
    int tid_ = threadIdx.x; asm volatile("" : "+v"(tid_));
    const int tid = tid_, wid = __builtin_amdgcn_readfirstlane(tid >> 6), lane = tid & 63, wr = wid >> 2, wc = wid & 3, fr = lane & 15, fq = lane >> 4;
    constexpr int K = KK, nt = K / BK;
    unsigned voffA[2], voffB[2];
#pragma unroll
    for (int i = 0; i < 2; ++i) { int R, C; stage_rc(tid * 16 + i * 8192, R, C); const int Rb = Epi::PERM ? ((R & ~31) + perm32(R & 31)) : R;
        voffA[i] = (unsigned)(R * LDA + C) * 2u; voffB[i] = (unsigned)(Rb * LDB + C) * 2u; }
    constexpr size_t kstep = (size_t)(BK * 2);
    constexpr size_t hstepA = (size_t)HALF * LDA * 2, hstepB = (size_t)HALF * LDB * 2;
    constexpr size_t tstepA = 2 * hstepA, tstepB = 2 * hstepB;
    const unsigned ldsw = (unsigned)wid * 1024u;
    const int aoff = lds_byte(wr * 64 + fr, fq * 8), boff = lds_byte(wc * 32 + fr, fq * 8);
#define PG8_SA(b, h) (((b) * 2 + (h)) * HTB)
#define PG8_SB(b, h) ((4 + (b) * 2 + (h)) * HTB)
#define PG8_STAGE(bufoff, gbase, voff) do { _Pragma("unroll") for (int _i = 0; _i < 2; ++_i) \
        __builtin_amdgcn_global_load_lds((const unsigned*)((const char*)(gbase) + (voff)[_i]), (PG8_LAS unsigned*)(lds + (bufoff) + ldsw + _i * 8192), 16, 0, 0); } while (0)
#define PG8_LDA(dst, b, h) do { _Pragma("unroll") for (int m = 0; m < 4; ++m) _Pragma("unroll") for (int k = 0; k < 2; ++k) dst[m][k] = *(const PG8_LAS bf16x8*)(lds + PG8_SA(b, h) + aoff + m * 2048 + k * 1024); } while (0)
#define PG8_LDB(dst, b, h) do { _Pragma("unroll") for (int n = 0; n < 2; ++n) _Pragma("unroll") for (int k = 0; k < 2; ++k) dst[n][k] = *(const PG8_LAS bf16x8*)(lds + PG8_SB(b, h) + boff + n * 2048 + k * 1024); } while (0)
#define PG8_MMA(ai, bj, At, Bt) do { __builtin_amdgcn_s_setprio(1); _Pragma("unroll") for (int m = 0; m < 4; ++m) _Pragma("unroll") for (int n = 0; n < 2; ++n) _Pragma("unroll") for (int k = 0; k < 2; ++k) \
        acc[ai][bj][m][n] = __builtin_amdgcn_mfma_f32_16x16x32_bf16(Bt[n][k], At[m][k], acc[ai][bj][m][n], 0, 0, 0); __builtin_amdgcn_s_setprio(0); } while (0)
#define PG8_WAIT_V(n) asm volatile("s_waitcnt vmcnt(" #n ")" ::: "memory")
#define PG8_WAIT_L(n) asm volatile("s_waitcnt lgkmcnt(" #n ")" ::: "memory")
#define PG8_BAR __builtin_amdgcn_s_barrier()
#define PG8_SCHED __builtin_amdgcn_sched_barrier(0)
    Unit cur, nxt; int ui = 0;
    if (!S.next(0, cur)) return;
    f32x4 acc[2][2][4][2];
#pragma unroll
    for (int a = 0; a < 2; ++a)
#pragma unroll
        for (int b = 0; b < 2; ++b)
#pragma unroll
            for (int m = 0; m < 4; ++m)
#pragma unroll
                for (int n = 0; n < 2; ++n) acc[a][b][m][n] = (f32x4){0.f, 0.f, 0.f, 0.f};
    bf16x8 At[4][2], B0[2][2], B1[2][2];
    const char* cA = (const char*)g.A + (size_t)cur.pm * tstepA; const char* cB = (const char*)g.Bt + (size_t)cur.pn * tstepB;
    S.a_ready(cur);
    if constexpr (SP2) {
        PG8_STAGE(PG8_SB(0, 0), cB, voffB); PG8_STAGE(PG8_SB(0, 1), cB + hstepB, voffB); PG8_STAGE(PG8_SA(0, 0), cA, voffA); PG8_STAGE(PG8_SA(0, 1), cA + hstepA, voffA);
        if (wr == 1) PG8_BAR;
        PG8_WAIT_V(2); PG8_BAR;
        PG8_STAGE(PG8_SB(1, 0), cB + kstep, voffB); PG8_STAGE(PG8_SA(1, 0), cA + kstep, voffA); PG8_STAGE(PG8_SB(1, 1), cB + hstepB + kstep, voffB);
        PG8_WAIT_V(6); PG8_BAR;
    } else {
        PG8_STAGE(PG8_SB(0, 0), cB, voffB); PG8_STAGE(PG8_SA(0, 0), cA, voffA); PG8_STAGE(PG8_SB(0, 1), cB + hstepB, voffB); PG8_STAGE(PG8_SA(0, 1), cA + hstepA, voffA);
        if (wr == 1) PG8_BAR;
        PG8_WAIT_V(4); PG8_BAR;
        PG8_STAGE(PG8_SB(1, 0), cB + kstep, voffB); PG8_STAGE(PG8_SA(1, 0), cA + kstep, voffA); PG8_STAGE(PG8_SB(1, 1), cB + hstepB + kstep, voffB);
        PG8_WAIT_V(6); PG8_BAR;
    }
    for (;;) {
        const bool has_next = S.next(ui + 1, nxt);
        const char* nA = has_next ? (const char*)g.A + (size_t)nxt.pm * tstepA : cA; const char* nB = has_next ? (const char*)g.Bt + (size_t)nxt.pn * tstepB : cB;
        for (int t = 0; t < nt; t += 2) {
            const bool last = (t == nt - 2);
            const char* a1 = cA + (size_t)(t + 1) * kstep;
            const char* a2 = last ? nA : cA + (size_t)(t + 2) * kstep; const char* b2 = last ? nB : cB + (size_t)(t + 2) * kstep;
            const char* a3 = a2 + kstep; const char* b3 = b2 + kstep;
            if (last && has_next) S.a_ready(nxt);
            if constexpr (SP2) {
            PG8_LDB(B0, 0, 0); PG8_LDB(B1, 0, 1); PG8_SCHED; PG8_LDA(At, 0, 0); PG8_STAGE(PG8_SA(1, 1), a1 + hstepA, voffA);
            PG8_WAIT_V(8); PG8_WAIT_L(0); PG8_BAR; PG8_MMA(0, 0, At, B0); PG8_MMA(0, 1, At, B1); PG8_BAR; PG8_SCHED;
            PG8_LDA(At, 0, 1); PG8_STAGE(PG8_SB(0, 0), b2, voffB); PG8_STAGE(PG8_SB(0, 1), b2 + hstepB, voffB); PG8_STAGE(PG8_SA(0, 0), a2, voffA);
            PG8_WAIT_V(8); PG8_WAIT_L(0); PG8_BAR; PG8_MMA(1, 0, At, B0); PG8_MMA(1, 1, At, B1); PG8_BAR; PG8_SCHED;
            PG8_LDB(B0, 1, 0); PG8_LDB(B1, 1, 1); PG8_SCHED; PG8_LDA(At, 1, 0); PG8_STAGE(PG8_SA(0, 1), a2 + hstepA, voffA);
            PG8_WAIT_V(8); PG8_WAIT_L(0); PG8_BAR; PG8_MMA(0, 0, At, B0); PG8_MMA(0, 1, At, B1); PG8_BAR; PG8_SCHED;
            PG8_LDA(At, 1, 1); PG8_STAGE(PG8_SB(1, 0), b3, voffB); PG8_STAGE(PG8_SB(1, 1), b3 + hstepB, voffB); PG8_STAGE(PG8_SA(1, 0), a3, voffA);
            PG8_WAIT_V(8); PG8_WAIT_L(0); PG8_BAR; PG8_MMA(1, 0, At, B0); PG8_MMA(1, 1, At, B1); PG8_BAR; PG8_SCHED;
            } else {
            PG8_LDB(B0, 0, 0); PG8_SCHED; PG8_LDA(At, 0, 0); PG8_STAGE(PG8_SA(1, 1), a1 + hstepA, voffA);
            PG8_WAIT_L(8); PG8_BAR; PG8_WAIT_L(0); PG8_MMA(0, 0, At, B0); PG8_BAR; PG8_SCHED;
            PG8_LDB(B1, 0, 1); PG8_STAGE(PG8_SB(0, 0), b2, voffB);
            PG8_BAR; PG8_WAIT_L(0); PG8_MMA(0, 1, At, B1); PG8_BAR;
            PG8_LDA(At, 0, 1); PG8_STAGE(PG8_SA(0, 0), a2, voffA);
            PG8_BAR; PG8_WAIT_L(0); PG8_MMA(1, 0, At, B0); PG8_BAR; PG8_SCHED;
            PG8_STAGE(PG8_SB(0, 1), b2 + hstepB, voffB);
            PG8_WAIT_V(6); PG8_BAR; PG8_MMA(1, 1, At, B1); PG8_BAR;
            PG8_LDB(B0, 1, 0); PG8_SCHED; PG8_LDA(At, 1, 0); PG8_STAGE(PG8_SA(0, 1), a2 + hstepA, voffA);
            PG8_WAIT_L(8); PG8_BAR; PG8_WAIT_L(0); PG8_MMA(0, 0, At, B0); PG8_BAR; PG8_SCHED;
            PG8_LDB(B1, 1, 1); PG8_STAGE(PG8_SB(1, 0), b3, voffB);
            PG8_BAR; PG8_WAIT_L(0); PG8_MMA(0, 1, At, B1); PG8_BAR;
            PG8_LDA(At, 1, 1); PG8_STAGE(PG8_SA(1, 0), a3, voffA);
            PG8_BAR; PG8_WAIT_L(0); PG8_MMA(1, 0, At, B0); PG8_BAR; PG8_SCHED;
            PG8_STAGE(PG8_SB(1, 1), b3 + hstepB, voffB);
            PG8_WAIT_V(6); PG8_BAR; PG8_MMA(1, 1, At, B1); PG8_BAR;
            }
        }
        if constexpr (ALIGN_EPI) { if (wr == 0) PG8_BAR; }
        if constexpr (!Epi::AFTER_DRAIN) { E(acc, cur, wr, wc, fr, fq); S.done(cur); }
        if (!has_next) break;
#pragma unroll
        for (int a = 0; a < 2; ++a)
#pragma unroll
            for (int b = 0; b < 2; ++b)
#pragma unroll
                for (int m = 0; m < 4; ++m)
#pragma unroll
                    for (int n = 0; n < 2; ++n) acc[a][b][m][n] = (f32x4){0.f, 0.f, 0.f, 0.f};
        cur = nxt; cA = nA; cB = nB; ++ui;
        if constexpr (ALIGN_EPI) { if (wr == 1) PG8_BAR; }
    }
    PG8_WAIT_V(0);
    if constexpr (!ALIGN_EPI) { if (wr == 0) PG8_BAR; }
    PG8_BAR;
    if constexpr (Epi::AFTER_DRAIN) { E.fused(acc, cur, wr, wc, fr, fq, lds, wid, lane); S.done(cur); }
#undef PG8_SA
#undef PG8_SB
#undef PG8_STAGE
#undef PG8_LDA
#undef PG8_LDB
#undef PG8_MMA
#undef PG8_WAIT_V
#undef PG8_WAIT_L
#undef PG8_BAR
#undef PG8_SCHED
}
}

constexpr int NWAVES = 8;
constexpr int NB = 2, L = 8192, D = 1024, DEPTH = 4, NC = 3352, NP = 3584, M = NB * L;
constexpr int C_RQ = 0, C_RK = 256, C_RV = 512, C_RG = 768, C_DQKV = 1024, C_DBETA = 1792, C_DA = 1796, C_DG = 1800,
              C_SU = 2056, C_SG = 2312, C_GQ = 2568, C_GK = 2696, C_GV = 2824, C_GCODE = 3080, C_GG = 3096;
constexpr float EPS = 1e-6f;
constexpr size_t MiB = 1u << 20;
constexpr size_t WS_CTL = 0, CTL_ZERO_BYTES = 1 * MiB;
constexpr size_t WS_TAB = 1 * MiB;
constexpr size_t WS_COEF = 3 * MiB;
constexpr size_t WS_WGLU = 4 * MiB;
constexpr size_t WS_WOUT = 5 * MiB;
constexpr size_t WS_WIN = 13 * MiB;
constexpr size_t WS_HY = 41 * MiB;
constexpr size_t WS_P = 73 * MiB;
constexpr size_t WS_END = 185 * MiB;
constexpr int COEF_STRIDE = 2048 + 32768;
constexpr int CW_BAR = 4096;
constexpr int RING_BYTES = 131072, LDSCTL_OFF = RING_BYTES, MISC_OFF = LDSCTL_OFF + 320, LDS_BYTES = 147456;

#define GAS __attribute__((address_space(1)))
#define LAS __attribute__((address_space(3)))
typedef unsigned short bf16;
typedef unsigned v4u __attribute__((ext_vector_type(4)));
typedef float f32x4 __attribute__((ext_vector_type(4)));
typedef float f32x2v __attribute__((ext_vector_type(2)));
typedef GAS unsigned gu32;
#define RLX_AGENT __ATOMIC_RELAXED, __HIP_MEMORY_SCOPE_AGENT
#define LDS_WAIT() asm volatile("s_waitcnt lgkmcnt(0)" ::: "memory")
#define VM_WAIT() asm volatile("s_waitcnt vmcnt(0)" ::: "memory")
__device__ __forceinline__ unsigned f2bf(float f) { unsigned u = __builtin_bit_cast(unsigned, f); return (u + 0x7fffu + ((u >> 16) & 1u)) >> 16; }
__device__ __forceinline__ unsigned pk2(float lo, float hi) { return f2bf(lo) | (f2bf(hi) << 16); }
__device__ __forceinline__ float bf2f(bf16 v) { return __builtin_bit_cast(float, (unsigned)v << 16); }
__device__ __forceinline__ float wave_sum(float v) {
#pragma unroll
    for (int o = 1; o < 64; o <<= 1) v += __shfl_xor(v, o);
    return v;
}
__device__ __forceinline__ float sigmoidf_(float x) { return 1.f / (1.f + expf(-x)); }
__device__ __forceinline__ float siluf_(float x) { return x * sigmoidf_(x); }
__device__ __forceinline__ float softplusf_(float x) { return fmaxf(x, 0.f) + log1pf(expf(-fabsf(x))); }
__device__ __forceinline__ float geluf_(float x) { return 0.5f * x * (1.f + tanhf(0.7978845608028654f * (x + 0.044715f * x * x * x))); }

#define XB_TMO      128
#define XB_XCNT(j)  (256  + 64 * (j))
#define XB_XSUB(j)  (1280 + 64 * (j))
#define XB_XGEN(j)  (2304 + 64 * (j))
#define XB_TOP      3328
#define XB_TOPGEN   3392
#define XCD_BAR_WORDS 3456
#define XB_SPIN_CAP (1u << 18)

__device__ __forceinline__ unsigned xb_ld(unsigned* p)              { return __hip_atomic_load(p, __ATOMIC_RELAXED, __HIP_MEMORY_SCOPE_AGENT); }
__device__ __forceinline__ unsigned xb_add(unsigned* p, unsigned v) { return __hip_atomic_fetch_add(p, v, __ATOMIC_RELAXED, __HIP_MEMORY_SCOPE_AGENT); }
__device__ __forceinline__ unsigned xb_xcc_id() { return (unsigned)__builtin_amdgcn_s_getreg((3 << 11) | 20) & 0xFu; }
#define XB_SPIN(cond, bar) do { unsigned _sp = 0; while (cond) { __builtin_amdgcn_s_sleep(1); \
    if ((++_sp & 255u) == 0u) { if (xb_ld(&(bar)[XB_TMO])) break; if (_sp > XB_SPIN_CAP) { atomicAdd(&(bar)[XB_TMO], 1u); break; } } } } while (0)

struct XcdBarrier {
    unsigned* bar; unsigned x;
    volatile LAS unsigned* st;
};

__device__ __forceinline__ XcdBarrier xcd_barrier_post(unsigned* bar, volatile LAS unsigned* st) {
    XcdBarrier b; b.bar = bar; b.x = xb_xcc_id(); b.st = st;
    if (threadIdx.x == 0) (void)xb_add(&bar[XB_XCNT(b.x)], 1u);
    return b;
}
__device__ __forceinline__ void xcd_barrier_complete(unsigned* bar, unsigned x, unsigned& nloc, unsigned& nx) {
    const unsigned G = gridDim.x * gridDim.y * gridDim.z;
    unsigned sum, cnt, mine, sp = 0u;
    for (;;) {
        sum = 0u; cnt = 0u; mine = 0u;
#pragma unroll
        for (unsigned j = 0; j < 16; ++j) { const unsigned c = xb_ld(&bar[XB_XCNT(j)]); sum += c; cnt += (c > 0u) ? 1u : 0u; mine = (j == x) ? c : mine; }
        if (sum == G) break;
        __builtin_amdgcn_s_sleep(1);
        if ((++sp & 255u) == 0u) { if (xb_ld(&bar[XB_TMO])) break; if (sp > XB_SPIN_CAP) { atomicAdd(&bar[XB_TMO], 1u); break; } }
    }
    nloc = mine > 0u ? mine : 1u; nx = cnt > 0u ? cnt : 1u;
}

__device__ __forceinline__ void xcd_barrier(const XcdBarrier& b) {
    asm volatile("s_waitcnt vmcnt(0)" ::: "memory");
    __syncthreads();
    if (threadIdx.x == 0) {
        unsigned* bar = b.bar; unsigned bx_ = b.x; asm volatile("" : "+s"(bx_));
        __builtin_amdgcn_s_waitcnt(0);
        unsigned nloc = b.st[0], nx = b.st[1];
        if (nloc == 0u) { xcd_barrier_complete(bar, bx_, nloc, nx); b.st[0] = nloc; b.st[1] = nx; }
        const unsigned old = xb_add(&bar[XB_XSUB(bx_)], 1u);
        const unsigned gen = old / nloc;
        if (old + 1u == (gen + 1u) * nloc) {
            __builtin_amdgcn_fence(__ATOMIC_RELEASE, "agent");
            asm volatile("s_waitcnt vmcnt(0)" ::: "memory");
            const unsigned og = xb_add(&bar[XB_TOP], 1u);
            const unsigned tg = og / nx;
            if (og + 1u == (tg + 1u) * nx) xb_add(&bar[XB_TOPGEN], 1u);
            else XB_SPIN(xb_ld(&bar[XB_TOPGEN]) == tg, bar);
            __builtin_amdgcn_fence(__ATOMIC_ACQUIRE, "agent");
            xb_add(&bar[XB_XGEN(bx_)], 1u);
            asm volatile("s_waitcnt vmcnt(0)" ::: "memory");
        } else {
            XB_SPIN(xb_ld(&bar[XB_XGEN(bx_)]) == gen, bar);
            __builtin_amdgcn_fence(__ATOMIC_ACQUIRE, "agent");
            asm volatile("s_waitcnt vmcnt(0)" ::: "memory");
        }
    }
    __syncthreads();
}

struct Args { const float* in[23]; float* out; unsigned char* ws; };

__device__ __forceinline__ void p0_transpose_item(const float* W, int K, int N, bf16* WT, LAS float* scr, int item, int lane) {
    const int nblk = (N + 31) / 32, kb = item / nblk, nb = item % nblk, k0 = 64 * kb, n0 = 32 * nb;
#pragma unroll 8
    for (int i = 0; i < 32; ++i) { const int kk = 2 * i + (lane >> 5), n = n0 + (lane & 31); scr[kk * 33 + (lane & 31)] = (n < N) ? W[(size_t)(k0 + kk) * N + n] : 0.f; }
    LDS_WAIT();
    const int c = lane & 7;
#pragma unroll
    for (int j = 0; j < 4; ++j) { const int n = (lane >> 3) + 8 * j; const LAS float* s = scr + (8 * c) * 33 + n;
        v4u o; o.x = pk2(s[0 * 33], s[1 * 33]); o.y = pk2(s[2 * 33], s[3 * 33]); o.z = pk2(s[4 * 33], s[5 * 33]); o.w = pk2(s[6 * 33], s[7 * 33]);
        *(GAS v4u*)(WT + (size_t)(n0 + n) * K + k0 + 8 * c) = o; }
    LDS_WAIT();
}

__device__ __forceinline__ void task_ret(LAS float* scr, const bf16* P, const f32x2v* tab, const float* norm_g, bf16* Y, int h, int lane) {
    const float gamma = 1.f - exp2f(-5.f - (float)h);
    float S[64];
#pragma unroll
    for (int d = 0; d < 64; ++d) S[d] = 0.f;
    const float gn = norm_g[lane];
    const bf16* pr = P + h * 64 + lane;
    bf16 nq = pr[C_RQ], nk = pr[C_RK], nv = pr[C_RV], ng = pr[C_RG]; f32x2v ncs = tab[lane >> 1];
    for (int t = 0; t < L; ++t) {
        const float q = bf2f(nq), k = bf2f(nk), v = bf2f(nv), gate = bf2f(ng); const float cs = ncs.x, sn = ncs.y;
        { const int tn = (t + 1 < L) ? t + 1 : t; const bf16* pn = pr + (size_t)tn * NP; nq = pn[C_RQ]; nk = pn[C_RK]; nv = pn[C_RV]; ng = pn[C_RG]; ncs = tab[tn * 32 + (lane >> 1)]; }
        const float qo = __shfl_xor(q, 1), ko = __shfl_xor(k, 1);
        const float qr = (lane & 1) ? (qo * sn + q * cs) : (q * cs - qo * sn);
        const float kr = (lane & 1) ? (ko * sn + k * cs) : (k * cs - ko * sn);
        scr[lane] = qr * 0.125f; scr[64 + lane] = kr;
        LDS_WAIT();
        float o = 0.f;
#pragma unroll
        for (int d = 0; d < 64; ++d) { S[d] = gamma * S[d] + scr[64 + d] * v; o += scr[d] * S[d]; }
        LDS_WAIT();
        const float ms = wave_sum(o * o) * (1.f / 64.f);
        Y[(size_t)t * D + 0 + h * 64 + lane] = (bf16)f2bf(o * rsqrtf(ms + EPS) * gn * siluf_(gate));
    }
}
__device__ __forceinline__ void task_dn(LAS float* scr, const bf16* P, const float* cw  , float a_log, float dt_bias, const float* norm_g, bf16* Y, int h, int lane) {
    float S[64];
#pragma unroll
    for (int d = 0; d < 64; ++d) S[d] = 0.f;
    const float gn = norm_g[lane], A = -expf(a_log);
    float wq[4], wk[4], wv[4];
#pragma unroll
    for (int j = 0; j < 4; ++j) { wq[j] = cw[j * 768 + h * 64 + lane]; wk[j] = cw[j * 768 + 256 + h * 64 + lane]; wv[j] = cw[j * 768 + 512 + h * 64 + lane]; }
    float xq0 = 0.f, xq1 = 0.f, xq2 = 0.f, xk0 = 0.f, xk1 = 0.f, xk2 = 0.f, xv0 = 0.f, xv1 = 0.f, xv2 = 0.f;
    const bf16* pr = P + h * 64 + lane;
    bf16 nq = pr[C_DQKV], nk = pr[C_DQKV + 256], nv = pr[C_DQKV + 512], ng = pr[C_DG], nb = P[C_DBETA + h], na = P[C_DA + h];
    for (int t = 0; t < L; ++t) {
        const float rq = bf2f(nq), rk = bf2f(nk), rv = bf2f(nv), gate = bf2f(ng), bin = bf2f(nb), ain = bf2f(na);
        { const int tn = (t + 1 < L) ? t + 1 : t; const bf16* pn = pr + (size_t)tn * NP; nq = pn[C_DQKV]; nk = pn[C_DQKV + 256]; nv = pn[C_DQKV + 512]; ng = pn[C_DG];
          nb = P[(size_t)tn * NP + C_DBETA + h]; na = P[(size_t)tn * NP + C_DA + h]; }
        float q = siluf_(wq[0] * xq0 + wq[1] * xq1 + wq[2] * xq2 + wq[3] * rq);
        float k = siluf_(wk[0] * xk0 + wk[1] * xk1 + wk[2] * xk2 + wk[3] * rk);
        const float v = siluf_(wv[0] * xv0 + wv[1] * xv1 + wv[2] * xv2 + wv[3] * rv);
        xq0 = xq1; xq1 = xq2; xq2 = rq; xk0 = xk1; xk1 = xk2; xk2 = rk; xv0 = xv1; xv1 = xv2; xv2 = rv;
        q = q * rsqrtf(wave_sum(q * q) + EPS) * 0.125f;
        k = k * rsqrtf(wave_sum(k * k) + EPS);
        const float beta = sigmoidf_(bin);
        const float eg = expf(A * softplusf_(ain + dt_bias));
        scr[lane] = q; scr[64 + lane] = k;
        LDS_WAIT();
        float ks = 0.f;
#pragma unroll
        for (int d = 0; d < 64; ++d) { S[d] *= eg; ks += scr[64 + d] * S[d]; }
        const float vn = beta * (v - ks);
        float o = 0.f;
#pragma unroll
        for (int d = 0; d < 64; ++d) { S[d] += scr[64 + d] * vn; o += scr[d] * S[d]; }
        LDS_WAIT();
        const float ms = wave_sum(o * o) * (1.f / 64.f);
        Y[(size_t)t * D + 256 + h * 64 + lane] = (bf16)f2bf(o * rsqrtf(ms + EPS) * gn * siluf_(gate));
    }
}
__device__ __forceinline__ void task_gla(LAS float* scr, const bf16* P, const float* w_gk  , const float* b_gk, const float* norm_g, bf16* Y, int h, int lane) {
    float S[32];
#pragma unroll
    for (int d = 0; d < 32; ++d) S[d] = 0.f;
    const float gn = norm_g[lane];
    const int dl = lane & 31;
    float wg[16];
#pragma unroll
    for (int r = 0; r < 16; ++r) wg[r] = w_gk[r * 128 + h * 32 + dl];
    const float bg = b_gk[h * 32 + dl];
    const float qs = 0.17677669529663687f;
    for (int t = 0; t < L; ++t) {
        const bf16* pr = P + (size_t)t * NP;
        float z = bg;
#pragma unroll
        for (int r = 0; r < 16; ++r) z += bf2f(pr[C_GCODE + r]) * wg[r];
        const float gk = -softplusf_(-z) * (1.f / 16.f);
        const float qd = bf2f(pr[C_GQ + h * 32 + dl]) * qs, kd = bf2f(pr[C_GK + h * 32 + dl]);
        const float v = bf2f(pr[C_GV + h * 64 + lane]), gate = bf2f(pr[C_GG + h * 64 + lane]);
        if (lane < 32) { scr[dl] = expf(gk); scr[32 + dl] = qd; scr[64 + dl] = kd; }
        LDS_WAIT();
        float o = 0.f;
#pragma unroll
        for (int d = 0; d < 32; ++d) { S[d] = scr[d] * S[d] + scr[64 + d] * v; o += scr[32 + d] * S[d]; }
        LDS_WAIT();
        const float ms = wave_sum(o * o) * (1.f / 64.f);
        Y[(size_t)t * D + 768 + h * 64 + lane] = (bf16)f2bf(o * rsqrtf(ms + EPS) * gn * siluf_(gate));
    }
}
__device__ __forceinline__ void task_s5(bf16* P, const float* coef, const float* c_re, const float* c_im, const float* dd, int g, int lane) {
    const int i = g * 64 + lane;
    const float ar = coef[i], ai = coef[1024 + i];
    float br[16], bi[16], cr[16], ci[16];
#pragma unroll
    for (int h = 0; h < 16; ++h) { br[h] = coef[2048 + i * 16 + h]; bi[h] = coef[2048 + 16384 + i * 16 + h]; cr[h] = c_re[(g * 16 + h) * 64 + lane]; ci[h] = c_im[(g * 16 + h) * 64 + lane]; }
    const float dmy = dd[g * 16 + (lane & 15)];
    float sr = 0.f, si = 0.f;
    for (int t = 0; t < L; ++t) {
        bf16* ur = P + (size_t)t * NP + C_SU + g * 16;
        float u[16];
#pragma unroll
        for (int h = 0; h < 16; ++h) u[h] = bf2f(ur[h]);
        float xr = 0.f, xi = 0.f;
#pragma unroll
        for (int h = 0; h < 16; ++h) { xr += br[h] * u[h]; xi += bi[h] * u[h]; }
        const float nr = ar * sr - ai * si + xr, ni = ar * si + ai * sr + xi;
        sr = nr; si = ni;
        float mine = 0.f, umine = 0.f;
#pragma unroll
        for (int h = 0; h < 16; ++h) { const float tot = wave_sum(cr[h] * sr - ci[h] * si); if ((lane & 15) == h) { mine = tot; umine = u[h]; } }
        if (lane < 16) ur[lane] = (bf16)f2bf(geluf_(mine + dmy * umine));
    }
}

__global__ void __launch_bounds__(NWAVES * 64, 2) hymba_fwd(Args args) {
    extern __shared__ __attribute__((aligned(16))) unsigned char lds[];
    LAS unsigned char* ldsb = (LAS unsigned char*)lds;
    volatile LAS unsigned* MISC = (volatile LAS unsigned*)(ldsb + MISC_OFF);
    const int tid = threadIdx.x, lane = tid & 63, wave = __builtin_amdgcn_readfirstlane(tid >> 6);
    const int G = gridDim.x, bx = blockIdx.x;
    unsigned char* ws = args.ws;
    gu32* ctl = (gu32*)(ws + WS_CTL);
    for (int u = tid; u < (LDS_BYTES - LDSCTL_OFF) / 4; u += NWAVES * 64) ((LAS unsigned*)(ldsb + LDSCTL_OFF))[u] = 0u;
    __syncthreads();
    XcdBarrier bar = xcd_barrier_post((unsigned*)(ctl + CW_BAR), MISC + 8);
#define GRID_BAR() xcd_barrier(bar)
    const float* x_in = args.in[0]; const float* norm_pre = args.in[1]; const float* norm_post = args.in[2]; const float* w_in = args.in[3]; const float* w_out = args.in[4];
    const float* ret_norm = args.in[5]; const float* dn_conv = args.in[6]; const float* dn_a_log = args.in[7]; const float* dn_dt_bias = args.in[8]; const float* dn_norm = args.in[9];
    const float* s5_lam_re = args.in[10]; const float* s5_lam_im = args.in[11]; const float* s5_b_re = args.in[12]; const float* s5_b_im = args.in[13];
    const float* s5_c_re = args.in[14]; const float* s5_c_im = args.in[15]; const float* s5_d = args.in[16]; const float* s5_log_dt = args.in[17];
    const float* s5_w_glu = args.in[18]; const float* s5_b_glu = args.in[19]; const float* gla_w_gk = args.in[20]; const float* gla_b_gk = args.in[21]; const float* gla_norm = args.in[22];
    float* X = args.out;
    f32x2v* TAB = (f32x2v*)(ws + WS_TAB);
    float* COEF = (float*)(ws + WS_COEF);
    bf16* WGLU = (bf16*)(ws + WS_WGLU); bf16* WOUT = (bf16*)(ws + WS_WOUT); bf16* WIN = (bf16*)(ws + WS_WIN);
    bf16* HY = (bf16*)(ws + WS_HY); bf16* P = (bf16*)(ws + WS_P); float* O32 = (float*)(ws + WS_P);
    const int gw = bx * NWAVES + wave, NGW = G * NWAVES;
    const int gt = bx * (NWAVES * 64) + tid, NGT = G * NWAVES * 64;

    {
        LAS float* scr = (LAS float*)(ldsb + wave * 16384);
        constexpr int I_IN = 16 * 105, I_OUT = 16 * 32, I_GLU = 4 * 8, I_L = I_IN + I_OUT + I_GLU;
        for (int it = gw; it < DEPTH * I_L; it += NGW) {
            const int l = it / I_L; int r = it % I_L;
            if (r < I_IN) { p0_transpose_item(w_in + (size_t)l * D * NC, D, NC, WIN + (size_t)l * NP * D, scr, r, lane); continue; } r -= I_IN;
            if (r < I_OUT) { p0_transpose_item(w_out + (size_t)l * D * D, D, D, WOUT + (size_t)l * D * D, scr, r, lane); continue; } r -= I_OUT;
            p0_transpose_item(s5_w_glu + (size_t)l * 65536, 256, 256, WGLU + (size_t)l * 65536, scr, r, lane);
        }
        for (int it = gt; it < DEPTH * 224 * 128; it += NGT) { const int l = it / (224 * 128), r = it % (224 * 128); ((GAS v4u*)(WIN + (size_t)l * NP * D + (size_t)3360 * D))[r] = (v4u){0u, 0u, 0u, 0u}; }
        for (int m = gw; m < M; m += NGW) {
            const GAS f32x4* xr = (const GAS f32x4*)(x_in + (size_t)m * D) + lane; GAS f32x4* xo = (GAS f32x4*)(X + (size_t)m * D) + lane;
            f32x4 v[4]; float s = 0.f;
#pragma unroll
            for (int j = 0; j < 4; ++j) { v[j] = xr[64 * j]; xo[64 * j] = v[j]; s += (v[j].x * v[j].x + v[j].y * v[j].y) + (v[j].z * v[j].z + v[j].w * v[j].w); }
            const float rstd = rsqrtf(wave_sum(s) * (1.f / D) + EPS);
            GAS unsigned long long* o8 = (GAS unsigned long long*)(HY + (size_t)m * D) + lane;
#pragma unroll
            for (int j = 0; j < 4; ++j) { const f32x4 gg = ((const GAS f32x4*)norm_pre)[lane + 64 * j];
                o8[64 * j] = (unsigned long long)pk2(v[j].x * rstd * gg.x, v[j].y * rstd * gg.y) | ((unsigned long long)pk2(v[j].z * rstd * gg.z, v[j].w * rstd * gg.w) << 32); }
        }
        for (int it = gt; it < L * 32; it += NGT) { const int t = it >> 5, i = it & 31; const float inv = powf(10000.f, -(float)(2 * i) / 64.f); float sn, cs; sincosf((float)t * inv, &sn, &cs); TAB[it] = (f32x2v){cs, sn}; }
        for (int it = gt; it < DEPTH * 1024; it += NGT) {
            const int l = it >> 10, i = it & 1023, g = i >> 6;
            const float dt = expf(s5_log_dt[l * 16 + g]);
            const float lr = s5_lam_re[it], li = s5_lam_im[it];
            const float mag = expf(lr * dt), ang = li * dt;
            const float ar = mag * cosf(ang), ai = mag * sinf(ang);
            const float den = lr * lr + li * li, nr = ar - 1.f, ni = ai;
            const float cr = (nr * lr + ni * li) / den, ci = (ni * lr - nr * li) / den;
            float* cf = COEF + (size_t)l * COEF_STRIDE;
            cf[i] = ar; cf[1024 + i] = ai;
            for (int h = 0; h < 16; ++h) { const float br = s5_b_re[(size_t)it * 16 + h], bi = s5_b_im[(size_t)it * 16 + h];
                cf[2048 + i * 16 + h] = cr * br - ci * bi; cf[2048 + 16384 + i * 16 + h] = cr * bi + ci * br; }
        }
    }
    GRID_BAR();

#pragma nounroll
    for (int l = 0; l < DEPTH; ++l) {
        int lane_l = tid & 63, bx_l = blockIdx.x; asm volatile("" : "+v"(lane_l)); asm volatile("" : "+s"(bx_l));
        const int lane = lane_l, bx = bx_l, gw = bx * NWAVES + wave;
        {
            pg8::Gemm g{HY, WIN + (size_t)l * NP * D, M, NP, D, D, D}; pg8::StaticOrder S; S.init(M, NP, G, bx);
            pg8::EpiStoreBf16 E{P, NP};
            pg8::gemm_phase<pg8::EpiStoreBf16, pg8::StaticOrder, true, true, D, D, D>(ldsb, g, S, E);
        }
        GRID_BAR();
        if (wave == 0) {
            LAS float* scr = (LAS float*)ldsb;
            if (bx < 8) { const int b = bx >> 2, h = bx & 3; task_ret(scr, P + (size_t)b * L * NP, TAB, ret_norm + l * 64, HY + (size_t)b * L * D, h, lane); }
            else if (bx < 16) { const int b = (bx - 8) >> 2, h = bx & 3; task_dn(scr, P + (size_t)b * L * NP, dn_conv + (size_t)l * 4 * 768, dn_a_log[l * 4 + h], dn_dt_bias[l * 4 + h], dn_norm + l * 64, HY + (size_t)b * L * D, h, lane); }
            else if (bx < 24) { const int b = (bx - 16) >> 2, h = bx & 3; task_gla(scr, P + (size_t)b * L * NP, gla_w_gk + (size_t)l * 16 * 128, gla_b_gk + l * 128, gla_norm + l * 64, HY + (size_t)b * L * D, h, lane); }
            else if (bx < 56) { const int b = (bx - 24) >> 4, g = (bx - 24) & 15; task_s5(P + (size_t)b * L * NP, COEF + (size_t)l * COEF_STRIDE, s5_c_re + (size_t)l * 16384, s5_c_im + (size_t)l * 16384, s5_d + l * 256, g, lane); }
        }
        GRID_BAR();
        {
            pg8::Gemm g{P + C_SU, WGLU + (size_t)l * 65536, M, 256, 256, NP, 256}; pg8::StaticOrder S; S.init(M, 256, G, bx);
            pg8::EpiGlu E{P + C_SU, P + C_SG, NP, s5_b_glu + l * 256, HY + 512, D};
            pg8::gemm_phase<pg8::EpiGlu, pg8::StaticOrder, true, true, 256, NP, 256>(ldsb, g, S, E);
        }
        GRID_BAR();
        {
            pg8::Gemm g{HY, WOUT + (size_t)l * D * D, M, D, D, D, D}; pg8::StaticOrder S; S.init(M, D, G, bx);
            pg8::EpiStoreF32 E{O32, D};
            pg8::gemm_phase<pg8::EpiStoreF32, pg8::StaticOrder, true, true, D, D, D>(ldsb, g, S, E);
        }
        GRID_BAR();
        for (int m = gw; m < M; m += NGW) {
            const GAS f32x4* orow = (const GAS f32x4*)(O32 + (size_t)m * D) + lane; GAS f32x4* xr = (GAS f32x4*)(X + (size_t)m * D) + lane;
            f32x4 o[4], xv[4]; float s = 0.f;
#pragma unroll
            for (int j = 0; j < 4; ++j) { o[j] = orow[64 * j]; xv[j] = xr[64 * j]; s += (o[j].x * o[j].x + o[j].y * o[j].y) + (o[j].z * o[j].z + o[j].w * o[j].w); }
            const float rstd = rsqrtf(wave_sum(s) * (1.f / D) + EPS);
            float s2 = 0.f;
#pragma unroll
            for (int j = 0; j < 4; ++j) { const f32x4 gg = ((const GAS f32x4*)(norm_post + l * D))[lane + 64 * j];
                xv[j].x += o[j].x * rstd * gg.x; xv[j].y += o[j].y * rstd * gg.y; xv[j].z += o[j].z * rstd * gg.z; xv[j].w += o[j].w * rstd * gg.w;
                xr[64 * j] = xv[j]; s2 += (xv[j].x * xv[j].x + xv[j].y * xv[j].y) + (xv[j].z * xv[j].z + xv[j].w * xv[j].w); }
            if (l + 1 < DEPTH) {
                const float r2 = rsqrtf(wave_sum(s2) * (1.f / D) + EPS);
                GAS unsigned long long* o8 = (GAS unsigned long long*)(HY + (size_t)m * D) + lane;
#pragma unroll
                for (int j = 0; j < 4; ++j) { const f32x4 gg = ((const GAS f32x4*)(norm_pre + (l + 1) * D))[lane + 64 * j];
                    o8[64 * j] = (unsigned long long)pk2(xv[j].x * r2 * gg.x, xv[j].y * r2 * gg.y) | ((unsigned long long)pk2(xv[j].z * r2 * gg.z, xv[j].w * r2 * gg.w) << 32); }
            }
        }
        if (l + 1 < DEPTH) GRID_BAR();
    }
}

extern "C" void kernel_launch(void* const* d_in, const int* in_sizes, int n_in, void* d_out, int out_size, void* d_ws, size_t ws_size, hipStream_t stream) {
    static int grid = 0;
    if (grid == 0) {
        if (n_in != 23 || out_size != M * D || ws_size < WS_END) { fprintf(stderr, "kernel_launch: unexpected shapes (n_in %d out %d ws %zu)\n", n_in, out_size, ws_size); grid = -1; return; }
        int dev = 0, cus = 0, per_cu = 0;
        if (hipGetDevice(&dev) != hipSuccess || hipDeviceGetAttribute(&cus, hipDeviceAttributeMultiprocessorCount, dev) != hipSuccess) { grid = -1; return; }
        if (hipFuncSetAttribute((const void*)hymba_fwd, hipFuncAttributeMaxDynamicSharedMemorySize, LDS_BYTES) != hipSuccess) { fprintf(stderr, "kernel_launch: hipFuncSetAttribute failed\n"); grid = -1; return; }
        if (hipOccupancyMaxActiveBlocksPerMultiprocessor(&per_cu, (const void*)hymba_fwd, NWAVES * 64, LDS_BYTES) != hipSuccess || per_cu < 1) { fprintf(stderr, "kernel_launch: occupancy query says %d blocks/CU\n", per_cu); grid = -1; return; }
        grid = cus;
    }
    if (grid < 0) return;
    (void)hipMemsetAsync((char*)d_ws + WS_CTL, 0, CTL_ZERO_BYTES, stream);
    Args a{};
    for (int i = 0; i < 23; ++i) a.in[i] = (const float*)d_in[i];
    a.out = (float*)d_out; a.ws = (unsigned char*)d_ws;
    void* kargs[] = {&a};
    const hipError_t e = hipLaunchCooperativeKernel((const void*)hymba_fwd, dim3(grid), dim3(NWAVES * 64), kargs, LDS_BYTES, stream);
    if (e != hipSuccess) fprintf(stderr, "cooperative launch failed: %s (grid %d)\n", hipGetErrorString(e), grid);
}
```

```cpp
#include <hip/hip_runtime.h>
#include <cstdio>
#include <cstdint>
#include <math.h>
#ifndef CH_RET
#define CH_RET 1
#endif
#ifndef CH_GLA
#define CH_GLA 1
#endif
namespace pg8 {
#define PG8_LAS __attribute__((address_space(3)))
typedef unsigned short bf16_t;
typedef short bf16x8 __attribute__((ext_vector_type(8)));
typedef float f32x4 __attribute__((ext_vector_type(4)));
typedef unsigned u32x4 __attribute__((ext_vector_type(4)));
constexpr int BM = 256, BK = 64, HALF = 128, HTB = HALF * BK * 2  , STAGE_BYTES = 8 * HTB, NXCD = 8, WGM = 8;

__host__ __device__ __forceinline__ int lds_byte(int r, int c) { const int st = (r >> 4) * 2 + (c >> 5), rr = r & 15, cc = c & 31, ob = rr * 64 + cc * 2; return st * 1024 + (ob ^ (((ob >> 9) & 1) << 5)); }
__host__ __device__ __forceinline__ void stage_rc(int b, int& R, int& C) { const int st = b / 1024, sb = b % 1024, swz = sb ^ (((sb >> 9) & 1) << 5); R = (st >> 1) * 16 + swz / 64; C = (st & 1) * 32 + (swz % 64) / 2; }
__host__ __device__ __forceinline__ int perm32(int rho) { const int n = rho >> 4, i = rho & 15; return 8 * (i >> 2) + 4 * n + (i & 3); }

struct Unit { int pm, pn; };
struct Gemm { const bf16_t* A; const bf16_t* Bt; int M, N, K, lda, ldb; };

struct StaticOrder {
    int nM, nN, nwg, G, c;
    __host__ __device__ void init(int M, int N, int G_, int c_) { nM = M / BM; nN = N / BM; nwg = nM * nN; G = G_; c = c_; }
    __host__ __device__ bool next(int i, Unit& u) const {
        const long L = (long)i * G + c; if (L >= nwg) return false;
        int wgid = (int)L; { const int q = nwg / NXCD, r = nwg % NXCD, xcd = wgid % NXCD, off = wgid / NXCD; wgid = (xcd < r ? xcd * (q + 1) : r * (q + 1) + (xcd - r) * q) + off; }
        const int nig = WGM * nN, gid = wgid / nig, fm = gid * WGM, gsz = (nM - fm) < WGM ? (nM - fm) : WGM;
        u.pm = fm + ((wgid % nig) % gsz); u.pn = (wgid % nig) / gsz; return true;
    }
    __device__ __forceinline__ void a_ready(const Unit&) const {}
    __device__ __forceinline__ void done(const Unit&) const {}
};

__device__ __forceinline__ unsigned cvt_pk_bf16(float lo, float hi) { unsigned r; asm volatile("v_cvt_pk_bf16_f32 %0, %1, %2" : "=v"(r) : "v"(lo), "v"(hi)); return r; }
__device__ __forceinline__ float bf_lo(unsigned w) { return __builtin_bit_cast(float, w << 16); }
__device__ __forceinline__ float bf_hi(unsigned w) { return __builtin_bit_cast(float, w & 0xffff0000u); }
struct EpiStoreBf16 {
    static constexpr bool PERM = true, AFTER_DRAIN = false;
    bf16_t* O; int ldc;
    __device__ __forceinline__ void operator()(const f32x4 (&acc)[2][2][4][2], const Unit& u, int wr, int wc, int fr, int fq) const {
        const int row0 = u.pm * BM + wr * 64 + fr, col0 = u.pn * BM + wc * 32 + 8 * fq;
#pragma unroll
        for (int ai = 0; ai < 2; ++ai)
#pragma unroll
            for (int m = 0; m < 4; ++m) { bf16_t* rowp = O + (size_t)(row0 + ai * HALF + m * 16) * ldc + col0;
#pragma unroll
                for (int bj = 0; bj < 2; ++bj) { const f32x4 v0 = acc[ai][bj][m][0], v1 = acc[ai][bj][m][1];
                    u32x4 w; w.x = cvt_pk_bf16(v0[0], v0[1]); w.y = cvt_pk_bf16(v0[2], v0[3]); w.z = cvt_pk_bf16(v1[0], v1[1]); w.w = cvt_pk_bf16(v1[2], v1[3]);
                    *(u32x4*)(rowp + bj * HALF) = w; } }
    }
};
struct EpiStoreF32 {
    static constexpr bool PERM = false, AFTER_DRAIN = false;
    float* C; int ldc;
    __device__ __forceinline__ void operator()(const f32x4 (&acc)[2][2][4][2], const Unit& u, int wr, int wc, int fr, int fq) const {
        const int row0 = u.pm * BM + wr * 64 + fr, col0 = u.pn * BM + wc * 32 + 4 * fq;
#pragma unroll
        for (int ai = 0; ai < 2; ++ai)
#pragma unroll
            for (int m = 0; m < 4; ++m) { float* rowp = C + (size_t)(row0 + ai * HALF + m * 16) * ldc + col0;
#pragma unroll
                for (int bj = 0; bj < 2; ++bj)
#pragma unroll
                    for (int n = 0; n < 2; ++n) *(f32x4*)(rowp + bj * HALF + n * 16) = acc[ai][bj][m][n]; }
    }
};
struct EpiGlu {
    static constexpr bool PERM = true, AFTER_DRAIN = false;
    const bf16_t* YG; const bf16_t* SG; int ldp; const float* bias; bf16_t* O; int ldo;
    __device__ __forceinline__ void operator()(const f32x4 (&acc)[2][2][4][2], const Unit& u, int wr, int wc, int fr, int fq) const {
        const int row0 = u.pm * BM + wr * 64 + fr, col0 = u.pn * BM + wc * 32 + 8 * fq;
#pragma unroll
        for (int ai = 0; ai < 2; ++ai)
#pragma unroll
            for (int m = 0; m < 4; ++m) { const size_t r = (size_t)(row0 + ai * HALF + m * 16);
#pragma unroll
                for (int bj = 0; bj < 2; ++bj) { const int c = col0 + bj * HALF;
                    const u32x4 yw = *(const u32x4*)(YG + r * ldp + c), gw = *(const u32x4*)(SG + r * ldp + c);
                    const f32x4 b0 = *(const f32x4*)(bias + c), b1 = *(const f32x4*)(bias + c + 4);
                    const f32x4 v0 = acc[ai][bj][m][0] + b0, v1 = acc[ai][bj][m][1] + b1;
                    float z[8] = {v0[0], v0[1], v0[2], v0[3], v1[0], v1[1], v1[2], v1[3]};
                    float yv[8] = {bf_lo(yw.x), bf_hi(yw.x), bf_lo(yw.y), bf_hi(yw.y), bf_lo(yw.z), bf_hi(yw.z), bf_lo(yw.w), bf_hi(yw.w)};
                    float gv[8] = {bf_lo(gw.x), bf_hi(gw.x), bf_lo(gw.y), bf_hi(gw.y), bf_lo(gw.z), bf_hi(gw.z), bf_lo(gw.w), bf_hi(gw.w)};
                    float o[8];
#pragma unroll
                    for (int e = 0; e < 8; ++e) { const float sz = 1.f / (1.f + __expf(-z[e])), sg = gv[e] / (1.f + __expf(-gv[e])); o[e] = yv[e] * sz * sg; }
                    u32x4 w; w.x = cvt_pk_bf16(o[0], o[1]); w.y = cvt_pk_bf16(o[2], o[3]); w.z = cvt_pk_bf16(o[4], o[5]); w.w = cvt_pk_bf16(o[6], o[7]);
                    *(u32x4*)(O + r * ldo + c) = w; } }
    }
};

template <class Epi, class Sched, bool ALIGN_EPI, bool SP2, int KK, int LDA, int LDB>
__device__ __forceinline__ void gemm_phase(PG8_LAS unsigned char* lds, const Gemm g, const Sched& S, const Epi& E, int tid_in) {
    int tid_ = tid_in; asm volatile("" : "+v"(tid_));
    const int tid = tid_, wid = __builtin_amdgcn_readfirstlane(tid >> 6), lane = tid & 63, wr = wid >> 2, wc = wid & 3, fr = lane & 15, fq = lane >> 4;
    constexpr int K = KK, nt = K / BK;
    unsigned voffA[2], voffB[2];
#pragma unroll
    for (int i = 0; i < 2; ++i) { int R, C; stage_rc(tid * 16 + i * 8192, R, C); const int Rb = Epi::PERM ? ((R & ~31) + perm32(R & 31)) : R;
        voffA[i] = (unsigned)(R * LDA + C) * 2u; voffB[i] = (unsigned)(Rb * LDB + C) * 2u; }
    constexpr size_t kstep = (size_t)(BK * 2);
    constexpr size_t hstepA = (size_t)HALF * LDA * 2, hstepB = (size_t)HALF * LDB * 2;
    constexpr size_t tstepA = 2 * hstepA, tstepB = 2 * hstepB;
    const unsigned ldsw = (unsigned)wid * 1024u;
    const int aoff = lds_byte(wr * 64 + fr, fq * 8), boff = lds_byte(wc * 32 + fr, fq * 8);
#define PG8_SA(b, h) (((b) * 2 + (h)) * HTB)
#define PG8_SB(b, h) ((4 + (b) * 2 + (h)) * HTB)
#define PG8_STAGE(bufoff, gbase, voff) do { _Pragma("unroll") for (int _i = 0; _i < 2; ++_i) \
        __builtin_amdgcn_global_load_lds((const unsigned*)((const char*)(gbase) + (voff)[_i]), (PG8_LAS unsigned*)(lds + (bufoff) + ldsw + _i * 8192), 16, 0, 0); } while (0)
#define PG8_LDA(dst, b, h) do { _Pragma("unroll") for (int m = 0; m < 4; ++m) _Pragma("unroll") for (int k = 0; k < 2; ++k) dst[m][k] = *(const PG8_LAS bf16x8*)(lds + PG8_SA(b, h) + aoff + m * 2048 + k * 1024); } while (0)
#define PG8_LDB(dst, b, h) do { _Pragma("unroll") for (int n = 0; n < 2; ++n) _Pragma("unroll") for (int k = 0; k < 2; ++k) dst[n][k] = *(const PG8_LAS bf16x8*)(lds + PG8_SB(b, h) + boff + n * 2048 + k * 1024); } while (0)
#define PG8_MMA(ai, bj, At, Bt) do { __builtin_amdgcn_s_setprio(1); _Pragma("unroll") for (int m = 0; m < 4; ++m) _Pragma("unroll") for (int n = 0; n < 2; ++n) _Pragma("unroll") for (int k = 0; k < 2; ++k) \
        acc[ai][bj][m][n] = __builtin_amdgcn_mfma_f32_16x16x32_bf16(Bt[n][k], At[m][k], acc[ai][bj][m][n], 0, 0, 0); __builtin_amdgcn_s_setprio(0); } while (0)
#define PG8_WAIT_V(n) asm volatile("s_waitcnt vmcnt(" #n ")" ::: "memory")
#define PG8_WAIT_L(n) asm volatile("s_waitcnt lgkmcnt(" #n ")" ::: "memory")
#define PG8_BAR __builtin_amdgcn_s_barrier()
#define PG8_SCHED __builtin_amdgcn_sched_barrier(0)
    Unit cur, nxt; int ui = 0;
    if (!S.next(0, cur)) return;
    f32x4 acc[2][2][4][2];
#pragma unroll
    for (int a = 0; a < 2; ++a)
#pragma unroll
        for (int b = 0; b < 2; ++b)
#pragma unroll
            for (int m = 0; m < 4; ++m)
#pragma unroll
                for (int n = 0; n < 2; ++n) acc[a][b][m][n] = (f32x4){0.f, 0.f, 0.f, 0.f};
    bf16x8 At[4][2], B0[2][2], B1[2][2];
    const char* cA = (const char*)g.A + (size_t)cur.pm * tstepA; const char* cB = (const char*)g.Bt + (size_t)cur.pn * tstepB;
    S.a_ready(cur);
    if constexpr (SP2) {
        PG8_STAGE(PG8_SB(0, 0), cB, voffB); PG8_STAGE(PG8_SB(0, 1), cB + hstepB, voffB); PG8_STAGE(PG8_SA(0, 0), cA, voffA); PG8_STAGE(PG8_SA(0, 1), cA + hstepA, voffA);
        if (wr == 1) PG8_BAR;
        PG8_WAIT_V(2); PG8_BAR;
        PG8_STAGE(PG8_SB(1, 0), cB + kstep, voffB); PG8_STAGE(PG8_SA(1, 0), cA + kstep, voffA); PG8_STAGE(PG8_SB(1, 1), cB + hstepB + kstep, voffB);
        PG8_WAIT_V(6); PG8_BAR;
    } else {
        PG8_STAGE(PG8_SB(0, 0), cB, voffB); PG8_STAGE(PG8_SA(0, 0), cA, voffA); PG8_STAGE(PG8_SB(0, 1), cB + hstepB, voffB); PG8_STAGE(PG8_SA(0, 1), cA + hstepA, voffA);
        if (wr == 1) PG8_BAR;
        PG8_WAIT_V(4); PG8_BAR;
        PG8_STAGE(PG8_SB(1, 0), cB + kstep, voffB); PG8_STAGE(PG8_SA(1, 0), cA + kstep, voffA); PG8_STAGE(PG8_SB(1, 1), cB + hstepB + kstep, voffB);
        PG8_WAIT_V(6); PG8_BAR;
    }
    for (;;) {
        const bool has_next = S.next(ui + 1, nxt);
        const char* nA = has_next ? (const char*)g.A + (size_t)nxt.pm * tstepA : cA; const char* nB = has_next ? (const char*)g.Bt + (size_t)nxt.pn * tstepB : cB;
        for (int t = 0; t < nt; t += 2) {
            const bool last = (t == nt - 2);
            const char* a1 = cA + (size_t)(t + 1) * kstep;
            const char* a2 = last ? nA : cA + (size_t)(t + 2) * kstep; const char* b2 = last ? nB : cB + (size_t)(t + 2) * kstep;
            const char* a3 = a2 + kstep; const char* b3 = b2 + kstep;
            if (last && has_next) S.a_ready(nxt);
            if constexpr (SP2) {
            PG8_LDB(B0, 0, 0); PG8_LDB(B1, 0, 1); PG8_SCHED; PG8_LDA(At, 0, 0); PG8_STAGE(PG8_SA(1, 1), a1 + hstepA, voffA);
            PG8_WAIT_V(8); PG8_WAIT_L(0); PG8_BAR; PG8_MMA(0, 0, At, B0); PG8_MMA(0, 1, At, B1); PG8_BAR; PG8_SCHED;
            PG8_LDA(At, 0, 1); PG8_STAGE(PG8_SB(0, 0), b2, voffB); PG8_STAGE(PG8_SB(0, 1), b2 + hstepB, voffB); PG8_STAGE(PG8_SA(0, 0), a2, voffA);
            PG8_WAIT_V(8); PG8_WAIT_L(0); PG8_BAR; PG8_MMA(1, 0, At, B0); PG8_MMA(1, 1, At, B1); PG8_BAR; PG8_SCHED;
            PG8_LDB(B0, 1, 0); PG8_LDB(B1, 1, 1); PG8_SCHED; PG8_LDA(At, 1, 0); PG8_STAGE(PG8_SA(0, 1), a2 + hstepA, voffA);
            PG8_WAIT_V(8); PG8_WAIT_L(0); PG8_BAR; PG8_MMA(0, 0, At, B0); PG8_MMA(0, 1, At, B1); PG8_BAR; PG8_SCHED;
            PG8_LDA(At, 1, 1); PG8_STAGE(PG8_SB(1, 0), b3, voffB); PG8_STAGE(PG8_SB(1, 1), b3 + hstepB, voffB); PG8_STAGE(PG8_SA(1, 0), a3, voffA);
            PG8_WAIT_V(8); PG8_WAIT_L(0); PG8_BAR; PG8_MMA(1, 0, At, B0); PG8_MMA(1, 1, At, B1); PG8_BAR; PG8_SCHED;
            } else {
            PG8_LDB(B0, 0, 0); PG8_SCHED; PG8_LDA(At, 0, 0); PG8_STAGE(PG8_SA(1, 1), a1 + hstepA, voffA);
            PG8_WAIT_L(8); PG8_BAR; PG8_WAIT_L(0); PG8_MMA(0, 0, At, B0); PG8_BAR; PG8_SCHED;
            PG8_LDB(B1, 0, 1); PG8_STAGE(PG8_SB(0, 0), b2, voffB);
            PG8_BAR; PG8_WAIT_L(0); PG8_MMA(0, 1, At, B1); PG8_BAR;
            PG8_LDA(At, 0, 1); PG8_STAGE(PG8_SA(0, 0), a2, voffA);
            PG8_BAR; PG8_WAIT_L(0); PG8_MMA(1, 0, At, B0); PG8_BAR; PG8_SCHED;
            PG8_STAGE(PG8_SB(0, 1), b2 + hstepB, voffB);
            PG8_WAIT_V(6); PG8_BAR; PG8_MMA(1, 1, At, B1); PG8_BAR;
            PG8_LDB(B0, 1, 0); PG8_SCHED; PG8_LDA(At, 1, 0); PG8_STAGE(PG8_SA(0, 1), a2 + hstepA, voffA);
            PG8_WAIT_L(8); PG8_BAR; PG8_WAIT_L(0); PG8_MMA(0, 0, At, B0); PG8_BAR; PG8_SCHED;
            PG8_LDB(B1, 1, 1); PG8_STAGE(PG8_SB(1, 0), b3, voffB);
            PG8_BAR; PG8_WAIT_L(0); PG8_MMA(0, 1, At, B1); PG8_BAR;
            PG8_LDA(At, 1, 1); PG8_STAGE(PG8_SA(1, 0), a3, voffA);
            PG8_BAR; PG8_WAIT_L(0); PG8_MMA(1, 0, At, B0); PG8_BAR; PG8_SCHED;
            PG8_STAGE(PG8_SB(1, 1), b3 + hstepB, voffB);
            PG8_WAIT_V(6); PG8_BAR; PG8_MMA(1, 1, At, B1); PG8_BAR;
            }
        }
        if constexpr (ALIGN_EPI) { if (wr == 0) PG8_BAR; }
        if constexpr (!Epi::AFTER_DRAIN) { E(acc, cur, wr, wc, fr, fq); S.done(cur); }
        if (!has_next) break;
#pragma unroll
        for (int a = 0; a < 2; ++a)
#pragma unroll
            for (int b = 0; b < 2; ++b)
#pragma unroll
                for (int m = 0; m < 4; ++m)
#pragma unroll
                    for (int n = 0; n < 2; ++n) acc[a][b][m][n] = (f32x4){0.f, 0.f, 0.f, 0.f};
        cur = nxt; cA = nA; cB = nB; ++ui;
        if constexpr (ALIGN_EPI) { if (wr == 1) PG8_BAR; }
    }
    PG8_WAIT_V(0);
    if constexpr (!ALIGN_EPI) { if (wr == 0) PG8_BAR; }
    PG8_BAR;
    if constexpr (Epi::AFTER_DRAIN) { E.fused(acc, cur, wr, wc, fr, fq, lds, wid, lane); S.done(cur); }
#undef PG8_SA
#undef PG8_SB
#undef PG8_STAGE
#undef PG8_LDA
#undef PG8_LDB
#undef PG8_MMA
#undef PG8_WAIT_V
#undef PG8_WAIT_L
#undef PG8_BAR
#undef PG8_SCHED
}
}

constexpr int NWAVES = 8;
constexpr int NB = 2, L = 8192, D = 1024, DEPTH = 4, NC = 3352, NP = 3584, M = NB * L;
constexpr int C_RQ = 0, C_RK = 256, C_RV = 512, C_RG = 768, C_DQKV = 1024, C_DBETA = 1792, C_DA = 1796, C_DG = 1800,
              C_SU = 2056, C_SG = 2312, C_GQ = 2568, C_GK = 2696, C_GV = 2824, C_GCODE = 3080, C_GG = 3096;
constexpr float EPS = 1e-6f;
constexpr size_t MiB = 1u << 20;
constexpr size_t WS_CTL = 0, CTL_ZERO_BYTES = 1 * MiB;
constexpr size_t WS_TAB = 1 * MiB;
constexpr size_t WS_COEF = 3 * MiB;
constexpr size_t WS_WGLU = 4 * MiB;
constexpr size_t WS_WOUT = 5 * MiB;
constexpr size_t WS_WIN = 7 * MiB;
constexpr size_t WS_HY = 14 * MiB;
constexpr size_t WS_P = 46 * MiB;
constexpr size_t WS_RET_RP = 158 * MiB;
constexpr size_t WS_GLA_RP = 166 * MiB;
constexpr size_t WS_GLA_DEC = 170 * MiB;
constexpr size_t WS_RET_KV = 171 * MiB;
constexpr size_t WS_GLA_KV = 187 * MiB;
constexpr size_t WS_END = 195 * MiB;
constexpr int COEF_STRIDE = 2048 + 32768;
constexpr int CW_BAR = 4096;
constexpr int RING_BYTES = 131072, LDSCTL_OFF = 155648  , MISC_OFF = LDSCTL_OFF + 320, ARGS_OFF = LDSCTL_OFF + 512, LDS_BYTES = 163840;

#define GAS __attribute__((address_space(1)))
#define LAS __attribute__((address_space(3)))
typedef unsigned short bf16;
typedef unsigned v4u __attribute__((ext_vector_type(4)));
typedef float f32x4 __attribute__((ext_vector_type(4)));
typedef float f32x2v __attribute__((ext_vector_type(2)));
typedef GAS unsigned gu32;
#define RLX_AGENT __ATOMIC_RELAXED, __HIP_MEMORY_SCOPE_AGENT
#define LDS_WAIT() asm volatile("s_waitcnt lgkmcnt(0)" ::: "memory")
#define VM_WAIT() asm volatile("s_waitcnt vmcnt(0)" ::: "memory")
__device__ __forceinline__ unsigned f2bf(float f) { unsigned u = __builtin_bit_cast(unsigned, f); return (u + 0x7fffu + ((u >> 16) & 1u)) >> 16; }
__device__ __forceinline__ unsigned pk2(float lo, float hi) { return f2bf(lo) | (f2bf(hi) << 16); }
__device__ __forceinline__ float bf2f(bf16 v) { return __builtin_bit_cast(float, (unsigned)v << 16); }
template <int MASK> __device__ __forceinline__ float swz_xor(float v) {
    return __builtin_bit_cast(float, __builtin_amdgcn_ds_swizzle(__builtin_bit_cast(int, v), (MASK << 10) | 0x1F));
}
__device__ __forceinline__ float xor32_add(float v) {
    unsigned a = __builtin_bit_cast(unsigned, v), b = a;
    asm volatile("s_nop 1\n\tv_permlane32_swap_b32 %0, %1" : "+v"(a), "+v"(b));
    return __builtin_bit_cast(float, a) + __builtin_bit_cast(float, b);
}
__device__ __forceinline__ float low_half_bcast(float v) {
    unsigned a = __builtin_bit_cast(unsigned, v), b = a;
    asm volatile("s_nop 1\n\tv_permlane32_swap_b32 %0, %1" : "+v"(a), "+v"(b));
    return __builtin_bit_cast(float, a);
}
__device__ __forceinline__ float wave_sum(float v) {
    v += swz_xor<1>(v); v += swz_xor<2>(v); v += swz_xor<4>(v); v += swz_xor<8>(v); v += swz_xor<16>(v);
    return xor32_add(v);
}
__device__ __forceinline__ float sigmoidf_(float x) { return 1.f / (1.f + expf(-x)); }
__device__ __forceinline__ float siluf_(float x) { return x * sigmoidf_(x); }
__device__ __forceinline__ float softplusf_(float x) { return fmaxf(x, 0.f) + log1pf(expf(-fabsf(x))); }
__device__ __forceinline__ float geluf_(float x) { return 0.5f * x * (1.f + tanhf(0.7978845608028654f * (x + 0.044715f * x * x * x))); }

#define XB_TMO      128
#define XB_XCNT(j)  (256  + 64 * (j))
#define XB_XSUB(j)  (1280 + 64 * (j))
#define XB_XGEN(j)  (2304 + 64 * (j))
#define XB_TOP      3328
#define XB_TOPGEN   3392
#define XCD_BAR_WORDS 3456
#define XB_SPIN_CAP (1u << 18)

__device__ __forceinline__ unsigned xb_ld(unsigned* p)              { return __hip_atomic_load(p, __ATOMIC_RELAXED, __HIP_MEMORY_SCOPE_AGENT); }
__device__ __forceinline__ unsigned xb_add(unsigned* p, unsigned v) { return __hip_atomic_fetch_add(p, v, __ATOMIC_RELAXED, __HIP_MEMORY_SCOPE_AGENT); }
__device__ __forceinline__ unsigned xb_xcc_id() { return (unsigned)__builtin_amdgcn_s_getreg((3 << 11) | 20) & 0xFu; }
#define XB_SPIN(cond, bar) do { unsigned _sp = 0; while (cond) { __builtin_amdgcn_s_sleep(1); \
    if ((++_sp & 255u) == 0u) { if (xb_ld(&(bar)[XB_TMO])) break; if (_sp > XB_SPIN_CAP) { atomicAdd(&(bar)[XB_TMO], 1u); break; } } } } while (0)

struct XcdBarrier {
    unsigned* bar; unsigned x;
    volatile LAS unsigned* st;
};

__device__ __forceinline__ XcdBarrier xcd_barrier_post(unsigned* bar, volatile LAS unsigned* st) {
    XcdBarrier b; b.bar = bar; b.x = xb_xcc_id(); b.st = st;
    if (threadIdx.x == 0) (void)xb_add(&bar[XB_XCNT(b.x)], 1u);
    return b;
}
__device__ __forceinline__ void xcd_barrier_complete(unsigned* bar, unsigned x, unsigned& nloc, unsigned& nx) {
    const unsigned G = gridDim.x * gridDim.y * gridDim.z;
    unsigned sum, cnt, mine, sp = 0u;
    for (;;) {
        sum = 0u; cnt = 0u; mine = 0u;
#pragma unroll
        for (unsigned j = 0; j < 16; ++j) { const unsigned c = xb_ld(&bar[XB_XCNT(j)]); sum += c; cnt += (c > 0u) ? 1u : 0u; mine = (j == x) ? c : mine; }
        if (sum == G) break;
        __builtin_amdgcn_s_sleep(1);
        if ((++sp & 255u) == 0u) { if (xb_ld(&bar[XB_TMO])) break; if (sp > XB_SPIN_CAP) { atomicAdd(&bar[XB_TMO], 1u); break; } }
    }
    nloc = mine > 0u ? mine : 1u; nx = cnt > 0u ? cnt : 1u;
}

__device__ __forceinline__ void xcd_barrier(const XcdBarrier& b) {
    asm volatile("s_waitcnt vmcnt(0)" ::: "memory");
    __syncthreads();
    if (threadIdx.x == 0) {
        unsigned* bar = b.bar; unsigned bx_ = b.x; asm volatile("" : "+s"(bx_));
        __builtin_amdgcn_s_waitcnt(0);
        unsigned nloc = b.st[0], nx = b.st[1];
        if (nloc == 0u) { xcd_barrier_complete(bar, bx_, nloc, nx); b.st[0] = nloc; b.st[1] = nx; }
        const unsigned old = xb_add(&bar[XB_XSUB(bx_)], 1u);
        const unsigned gen = old / nloc;
        if (old + 1u == (gen + 1u) * nloc) {
            __builtin_amdgcn_fence(__ATOMIC_RELEASE, "agent");
            asm volatile("s_waitcnt vmcnt(0)" ::: "memory");
            const unsigned og = xb_add(&bar[XB_TOP], 1u);
            const unsigned tg = og / nx;
            if (og + 1u == (tg + 1u) * nx) xb_add(&bar[XB_TOPGEN], 1u);
            else XB_SPIN(xb_ld(&bar[XB_TOPGEN]) == tg, bar);
            __builtin_amdgcn_fence(__ATOMIC_ACQUIRE, "agent");
            xb_add(&bar[XB_XGEN(bx_)], 1u);
            asm volatile("s_waitcnt vmcnt(0)" ::: "memory");
        } else {
            XB_SPIN(xb_ld(&bar[XB_XGEN(bx_)]) == gen, bar);
            __builtin_amdgcn_fence(__ATOMIC_ACQUIRE, "agent");
            asm volatile("s_waitcnt vmcnt(0)" ::: "memory");
        }
    }
    __syncthreads();
}

namespace mx {
typedef short bf16x8 __attribute__((ext_vector_type(8)));
typedef short s16x4 __attribute__((ext_vector_type(4)));
typedef float f32x16 __attribute__((ext_vector_type(16)));
constexpr int IROW = 144, IMG_BYTES = 64 * IROW, WLDS = 2 * IMG_BYTES + 1024;
__device__ __forceinline__ int crow(int reg, int h) { return (reg & 3) + 8 * (reg >> 2) + 4 * h; }
__device__ __forceinline__ bf16x8 frag_row(const LAS unsigned char* img, int r0, int c0, int lane) {
    return *(const LAS bf16x8*)(img + (r0 + (lane & 31)) * IROW + (c0 + 8 * (lane >> 5)) * 2);
}
__device__ __forceinline__ bf16x8 frag_tr(const LAS unsigned char* img, int r0, int c0, int lane) {
    const int g = lane >> 4, i = lane & 15, q = i >> 2, p = i & 3;
    LAS unsigned char* a = (LAS unsigned char*)img + (r0 + 8 * (g >> 1) + q) * IROW + (c0 + 16 * (g & 1) + 4 * p) * 2;
    const s16x4 lo = __builtin_amdgcn_ds_read_tr16_b64_v4i16((LAS s16x4*)a);
    const s16x4 hi = __builtin_amdgcn_ds_read_tr16_b64_v4i16((LAS s16x4*)(a + 4 * IROW));
    return (bf16x8){lo[0], lo[1], lo[2], lo[3], hi[0], hi[1], hi[2], hi[3]};
}
__device__ __forceinline__ bf16x8 frag_row_perm(const LAS unsigned char* img, int r0, int c0, int lane) {
    const LAS unsigned char* a = img + (r0 + (lane & 31)) * IROW + (c0 + 4 * (lane >> 5)) * 2;
    const s16x4 lo = *(const LAS s16x4*)a, hi = *(const LAS s16x4*)(a + 16);
    return (bf16x8){lo[0], lo[1], lo[2], lo[3], hi[0], hi[1], hi[2], hi[3]};
}
__device__ __forceinline__ f32x16 mfma(bf16x8 a, bf16x8 b, f32x16 c) { return __builtin_amdgcn_mfma_f32_32x32x16_bf16(a, b, c, 0, 0, 0); }
__device__ __forceinline__ f32x16 zero16() { f32x16 z; for (int i = 0; i < 16; ++i) z[i] = 0.f; return z; }
__device__ __forceinline__ void unpack8(v4u w, float (&f)[8]) {
    f[0] = __builtin_bit_cast(float, w.x << 16); f[1] = __builtin_bit_cast(float, w.x & 0xffff0000u); f[2] = __builtin_bit_cast(float, w.y << 16); f[3] = __builtin_bit_cast(float, w.y & 0xffff0000u);
    f[4] = __builtin_bit_cast(float, w.z << 16); f[5] = __builtin_bit_cast(float, w.z & 0xffff0000u); f[6] = __builtin_bit_cast(float, w.w << 16); f[7] = __builtin_bit_cast(float, w.w & 0xffff0000u);
}
__device__ __forceinline__ v4u pack8(const float (&f)[8]) { v4u w; w.x = pk2(f[0], f[1]); w.y = pk2(f[2], f[3]); w.z = pk2(f[4], f[5]); w.w = pk2(f[6], f[7]); return w; }
template <int NCOL> __device__ __forceinline__ void img_load(LAS unsigned char* img, const bf16* g, int ld, int lane) {
    constexpr int CPR = NCOL / 8;
#pragma unroll
    for (int it = 0; it < CPR; ++it) { int c_ = lane + 64 * it; asm volatile("" : "+v"(c_)); const int c = c_, row = c / CPR, cc = c % CPR;
        *(LAS v4u*)(img + row * IROW + cc * 16) = *(const GAS v4u*)(g + (size_t)row * ld + cc * 8); }
}
template <int DK, class RS> __device__ __forceinline__ void la_kv(const LAS unsigned char* imgK, const LAS unsigned char* imgV, float* KV, const RS& rs, int lane) {
#pragma unroll
    for (int md = 0; md < DK / 32; ++md)
#pragma unroll
        for (int et = 0; et < 2; ++et) {
            f32x16 acc = zero16();
#pragma unroll
            for (int s = 0; s < 4; ++s) acc = mfma(frag_tr(imgK, 16 * s, 32 * md, lane), frag_tr(imgV, 16 * s, 32 * et, lane), acc);
#pragma unroll
            for (int u = 0; u < 2; ++u) { f32x4 o0, o1;
#pragma unroll
                for (int j = 0; j < 4; ++j) { o0[j] = acc[8 * u + j] * rs(32 * md + crow(8 * u + j, lane >> 5)); o1[j] = acc[8 * u + 4 + j] * rs(32 * md + crow(8 * u + 4 + j, lane >> 5)); }
                GAS f32x4* dst = (GAS f32x4*)(KV + ((size_t)((md * 2 + et) * 2 + u) * 64 + lane) * 8); dst[0] = o0; dst[1] = o1; }
        }
}
template <int DK> __device__ __forceinline__ void la_out(LAS unsigned char* wl, const bf16* Qp, const bf16* Kp, int ldq, const bf16* Vp, const bf16* Gp, int ldp,
                                                         const bf16* RP, const float* norm_g, bf16* Yp, int ldy, int lane) {
    LAS unsigned char* img0 = wl; LAS unsigned char* img1 = wl + IMG_BYTES;
    img_load<DK>(img0, Qp, ldq, lane); img_load<DK>(img1, Kp, ldq, lane);
    f32x16 sc[3];
#pragma unroll
    for (int t = 0; t < 3; ++t) { const int mt = (t == 1) ? 0 : 1, nt = (t == 0) ? 0 : (t == 1 ? 0 : 1); sc[t] = zero16();
#pragma unroll
        for (int s = 0; s < DK / 16; ++s) sc[t] = mfma(frag_row(img0, 32 * mt, 16 * s, lane), frag_row(img1, 32 * nt, 16 * s, lane), sc[t]); }
    f32x16 o[2][2];
#pragma unroll
    for (int et = 0; et < 2; ++et)
#pragma unroll
        for (int it = 0; it < 2; ++it) { o[et][it] = zero16();
#pragma unroll
            for (int md = 0; md < DK / 32; ++md)
#pragma unroll
                for (int u = 0; u < 2; ++u) { const bf16x8 a = *(const GAS bf16x8*)(RP + ((size_t)((md * 2 + et) * 2 + u) * 64 + lane) * 8);
                    o[et][it] = mfma(a, frag_row_perm(img0, 32 * it, 32 * md + 16 * u, lane), o[et][it]); } }
#pragma unroll
    for (int t = 0; t < 3; ++t) { const int mt = (t == 1) ? 0 : 1, nt = (t == 0) ? 0 : (t == 1 ? 0 : 1);
#pragma unroll
        for (int r = 0; r < 16; ++r) { const int i = 32 * mt + crow(r, lane >> 5), j = 32 * nt + (lane & 31);
            *(LAS bf16*)(img0 + i * IROW + j * 2) = (bf16)f2bf(j <= i ? sc[t][r] : 0.f); } }
#pragma unroll
    for (int r = 0; r < 16; ++r) { const int i = crow(r, lane >> 5), j = 32 + (lane & 31); *(LAS bf16*)(img0 + i * IROW + j * 2) = 0; }
    img_load<64>(img1, Vp, ldp, lane);
#pragma unroll
    for (int et = 0; et < 2; ++et)
#pragma unroll
        for (int it = 0; it < 2; ++it)
#pragma unroll
            for (int s = 0; s < 4; ++s) { if (it == 0 && s >= 2) continue;
                o[et][it] = mfma(frag_tr(img1, 16 * s, 32 * et, lane), frag_row(img0, 32 * it, 16 * s, lane), o[et][it]); }
#pragma unroll
    for (int it = 0; it < 2; ++it) {
        float ss = 0.f;
#pragma unroll
        for (int et = 0; et < 2; ++et)
#pragma unroll
            for (int r = 0; r < 16; ++r) ss += o[et][it][r] * o[et][it][r];
        ss = xor32_add(ss);
        const float rstd = rsqrtf(ss * (1.f / 64.f) + EPS);
        const int i = 32 * it + (lane & 31);
#pragma unroll
        for (int et = 0; et < 2; ++et)
#pragma unroll
            for (int g4 = 0; g4 < 4; ++g4) { const int e0 = 32 * et + 8 * g4 + 4 * (lane >> 5); int i_ = i; asm volatile("" : "+v"(i_));
                const unsigned long long gw = *(const GAS unsigned long long*)(Gp + (size_t)i_ * ldp + e0);
                const f32x4 gn = *(const GAS f32x4*)(norm_g + e0);
                float gt[4] = {__builtin_bit_cast(float, (unsigned)gw << 16), __builtin_bit_cast(float, (unsigned)gw & 0xffff0000u),
                               __builtin_bit_cast(float, (unsigned)(gw >> 32) << 16), __builtin_bit_cast(float, (unsigned)(gw >> 32) & 0xffff0000u)};
                float ov[4];
#pragma unroll
                for (int j = 0; j < 4; ++j) ov[j] = o[et][it][4 * g4 + j] * rstd * gn[j] * (gt[j] / (1.f + __expf(-gt[j])));
                *(GAS unsigned long long*)(Yp + (size_t)i_ * ldy + e0) = (unsigned long long)pk2(ov[0], ov[1]) | ((unsigned long long)pk2(ov[2], ov[3]) << 32); }
    }
}
}

__device__ __forceinline__ void ret_A(LAS unsigned char* wl, bf16* Pt  , const f32x2v* tab, int pos0, int h, float* KV, int lane) {
    LAS unsigned char* img0 = wl; LAS unsigned char* img1 = wl + mx::IMG_BYTES;
    const float lg = log2f(1.f - exp2f(-5.f - (float)h));
    const int cc = lane & 7;
#pragma unroll
    for (int it = 0; it < 8; ++it) { int row_ = (lane >> 3) + 8 * it; asm volatile("" : "+v"(row_)); const int row = row_;
        bf16* qp = Pt + (size_t)row * NP + C_RQ + h * 64 + cc * 8; bf16* kp = Pt + (size_t)row * NP + C_RK + h * 64 + cc * 8;
        float q[8], k[8]; mx::unpack8(*(const GAS v4u*)qp, q); mx::unpack8(*(const GAS v4u*)kp, k);
        const GAS f32x4* tp = (const GAS f32x4*)(tab + (size_t)(pos0 + row) * 32 + cc * 4); const f32x4 t0 = tp[0], t1 = tp[1];
        const float cs[4] = {t0[0], t0[2], t1[0], t1[2]}, sn[4] = {t0[1], t0[3], t1[1], t1[3]};
        const float dq = 0.125f * exp2f((float)(row + 1) * lg), dk = exp2f(-(float)(row + 1) * lg);
        float qo[8], ko[8];
#pragma unroll
        for (int pz = 0; pz < 4; ++pz) { qo[2 * pz] = (q[2 * pz] * cs[pz] - q[2 * pz + 1] * sn[pz]) * dq; qo[2 * pz + 1] = (q[2 * pz] * sn[pz] + q[2 * pz + 1] * cs[pz]) * dq;
            ko[2 * pz] = (k[2 * pz] * cs[pz] - k[2 * pz + 1] * sn[pz]) * dk; ko[2 * pz + 1] = (k[2 * pz] * sn[pz] + k[2 * pz + 1] * cs[pz]) * dk; }
        const v4u kw = mx::pack8(ko);
        *(GAS v4u*)qp = mx::pack8(qo); *(GAS v4u*)kp = kw;
        *(LAS v4u*)(img0 + row * mx::IROW + cc * 16) = kw; }
    mx::img_load<64>(img1, Pt + C_RV + h * 64, NP, lane);
    const float g64 = exp2f(64.f * lg);
    mx::la_kv<64>(img0, img1, KV, [g64](int) { return g64; }, lane);
}
__device__ __forceinline__ void gla_A(LAS unsigned char* wl, bf16* Pt, const float* w_gk  , const float* b_gk, int h, float* KV, float* DEC, int lane) {
    LAS unsigned char* img0 = wl; LAS unsigned char* img1 = wl + mx::IMG_BYTES; LAS float* vec = (LAS float*)(wl + 2 * mx::IMG_BYTES);
    LAS float* cumL = (LAS float*)img1;
    const int hh = lane >> 5, d = lane & 31;
    float wg[16];
#pragma unroll
    for (int r = 0; r < 16; ++r) wg[r] = w_gk[r * 128 + h * 32 + d];
    const float bg = b_gk[h * 32 + d];
    float cum = 0.f;
    { const bf16* pr = Pt + (size_t)(32 * hh) * NP + C_GCODE;
#pragma unroll 4
      for (int jj = 0; jj < 32; ++jj, pr += NP) {
        float a[8], b[8]; mx::unpack8(*(const GAS v4u*)pr, a); mx::unpack8(*(const GAS v4u*)(pr + 8), b);
        float z = bg;
#pragma unroll
        for (int r = 0; r < 8; ++r) z += a[r] * wg[r] + b[r] * wg[8 + r];
        cum += -softplusf_(-z) * (1.f / 16.f); cumL[(32 * hh + jj) * 32 + d] = cum; } }
    const float first_tot = low_half_bcast(cum);
    const float add = hh ? first_tot : 0.f;
    if (hh) vec[d] = expf(cum + first_tot);
    const float qs = 0.17677669529663687f;
    { GAS bf16* qp = (GAS bf16*)(Pt + (size_t)(32 * hh) * NP + C_GQ + h * 32 + d); GAS bf16* kp = (GAS bf16*)(Pt + (size_t)(32 * hh) * NP + C_GK + h * 32 + d);
#pragma unroll 4
      for (int jj = 0; jj < 32; ++jj, qp += NP, kp += NP) { const int row = 32 * hh + jj;
        const float e = expf(cumL[row * 32 + d] + add);
        const bf16 qv = (bf16)f2bf(bf2f(*qp) * qs * e), kv = (bf16)f2bf(bf2f(*kp) / e);
        *qp = qv; *kp = kv; *(LAS bf16*)(img0 + row * mx::IROW + d * 2) = kv; } }
    LDS_WAIT();
    mx::img_load<64>(img1, Pt + C_GV + h * 64, NP, lane);
    if (lane < 32) DEC[lane] = vec[lane];
    mx::la_kv<32>(img0, img1, KV, [vec](int dd) { return vec[dd]; }, lane);
}
template <int NMD> __device__ __forceinline__ void la_scan(const float* KV, bf16* RP, const float* DEC, float g64, int sub  , int lane) {
    constexpr int CH = NMD * 4 * 64 * 8;
    const int u = sub & 1, h = lane >> 5;
    float st[8];
#pragma unroll
    for (int j = 0; j < 8; ++j) st[j] = 0.f;
    const float* kp = KV + ((size_t)sub * 64 + lane) * 8; bf16* rp = RP + ((size_t)sub * 64 + lane) * 8;
    for (int n0 = 0; n0 < 128; n0 += 8) {
        f32x4 a[8][2], dc[8][2];
#pragma unroll
        for (int n = 0; n < 8; ++n) { const GAS f32x4* src = (const GAS f32x4*)(kp + (size_t)(n0 + n) * CH); a[n][0] = src[0]; a[n][1] = src[1];
            if (DEC) { const float* dp = DEC + (size_t)(n0 + n) * 32 + 16 * u + 4 * h; dc[n][0] = *(const GAS f32x4*)dp; dc[n][1] = *(const GAS f32x4*)(dp + 8); }
            else { dc[n][0] = (f32x4){g64, g64, g64, g64}; dc[n][1] = dc[n][0]; } }
#pragma unroll
        for (int n = 0; n < 8; ++n) {
            *(GAS v4u*)(rp + (size_t)(n0 + n) * CH) = mx::pack8(st);
#pragma unroll
            for (int j = 0; j < 4; ++j) { st[j] = st[j] * dc[n][0][j] + a[n][0][j]; st[4 + j] = st[4 + j] * dc[n][1][j] + a[n][1][j]; }
        }
    }
}

struct Args { const float* in[23]; float* out; unsigned char* ws; };

__device__ __forceinline__ void p0_transpose_item(const float* W, int K, int N, bf16* WT, LAS float* scr, int item, int lane) {
    const int nblk = (N + 31) / 32, kb = item / nblk, nb = item % nblk, k0 = 64 * kb, n0 = 32 * nb;
#pragma unroll 8
    for (int i = 0; i < 32; ++i) { const int kk = 2 * i + (lane >> 5), n = n0 + (lane & 31); scr[kk * 33 + (lane & 31)] = (n < N) ? W[(size_t)(k0 + kk) * N + n] : 0.f; }
    LDS_WAIT();
    const int c = lane & 7;
#pragma unroll
    for (int j = 0; j < 4; ++j) { const int n = (lane >> 3) + 8 * j; const LAS float* s = scr + (8 * c) * 33 + n;
        v4u o; o.x = pk2(s[0 * 33], s[1 * 33]); o.y = pk2(s[2 * 33], s[3 * 33]); o.z = pk2(s[4 * 33], s[5 * 33]); o.w = pk2(s[6 * 33], s[7 * 33]);
        *(GAS v4u*)(WT + (size_t)(n0 + n) * K + k0 + 8 * c) = o; }
    LDS_WAIT();
}

__device__ __forceinline__ void task_ret(LAS float* scr, const bf16* P, const f32x2v* tab, const float* norm_g, bf16* Y, int h, int lane) {
    const float gamma = 1.f - exp2f(-5.f - (float)h);
    float S[64];
#pragma unroll
    for (int d = 0; d < 64; ++d) S[d] = 0.f;
    const float gn = norm_g[lane];
    const bf16* pr = P + h * 64 + lane;
    bf16 nq = pr[C_RQ], nk = pr[C_RK], nv = pr[C_RV], ng = pr[C_RG]; f32x2v ncs = tab[lane >> 1];
    for (int t = 0; t < L; ++t) {
        const float q = bf2f(nq), k = bf2f(nk), v = bf2f(nv), gate = bf2f(ng); const float cs = ncs.x, sn = ncs.y;
        { const int tn = (t + 1 < L) ? t + 1 : t; const bf16* pn = pr + (size_t)tn * NP; nq = pn[C_RQ]; nk = pn[C_RK]; nv = pn[C_RV]; ng = pn[C_RG]; ncs = tab[tn * 32 + (lane >> 1)]; }
        const float qo = swz_xor<1>(q), ko = swz_xor<1>(k);
        const float qr = (lane & 1) ? (qo * sn + q * cs) : (q * cs - qo * sn);
        const float kr = (lane & 1) ? (ko * sn + k * cs) : (k * cs - ko * sn);
        scr[lane] = qr * 0.125f; scr[64 + lane] = kr;
        LDS_WAIT();
        float o = 0.f;
#pragma unroll
        for (int d = 0; d < 64; ++d) { S[d] = gamma * S[d] + scr[64 + d] * v; o += scr[d] * S[d]; }
        LDS_WAIT();
        const float ms = wave_sum(o * o) * (1.f / 64.f);
        Y[(size_t)t * D + 0 + h * 64 + lane] = (bf16)f2bf(o * rsqrtf(ms + EPS) * gn * siluf_(gate));
    }
}
__device__ __forceinline__ void task_dn(LAS float* scr, const bf16* P, const float* cw  , float a_log, float dt_bias, const float* norm_g, bf16* Y, int h, int lane) {
    float S[64];
#pragma unroll
    for (int d = 0; d < 64; ++d) S[d] = 0.f;
    const float gn = norm_g[lane], A = -expf(a_log);
    float wq[4], wk[4], wv[4];
#pragma unroll
    for (int j = 0; j < 4; ++j) { wq[j] = cw[j * 768 + h * 64 + lane]; wk[j] = cw[j * 768 + 256 + h * 64 + lane]; wv[j] = cw[j * 768 + 512 + h * 64 + lane]; }
    float xq0 = 0.f, xq1 = 0.f, xq2 = 0.f, xk0 = 0.f, xk1 = 0.f, xk2 = 0.f, xv0 = 0.f, xv1 = 0.f, xv2 = 0.f;
    const bf16* pr = P + h * 64 + lane;
    bf16 nq = pr[C_DQKV], nk = pr[C_DQKV + 256], nv = pr[C_DQKV + 512], ng = pr[C_DG], nb = P[C_DBETA + h], na = P[C_DA + h];
    for (int t = 0; t < L; ++t) {
        const float rq = bf2f(nq), rk = bf2f(nk), rv = bf2f(nv), gate = bf2f(ng), bin = bf2f(nb), ain = bf2f(na);
        { const int tn = (t + 1 < L) ? t + 1 : t; const bf16* pn = pr + (size_t)tn * NP; nq = pn[C_DQKV]; nk = pn[C_DQKV + 256]; nv = pn[C_DQKV + 512]; ng = pn[C_DG];
          nb = P[(size_t)tn * NP + C_DBETA + h]; na = P[(size_t)tn * NP + C_DA + h]; }
        float q = siluf_(wq[0] * xq0 + wq[1] * xq1 + wq[2] * xq2 + wq[3] * rq);
        float k = siluf_(wk[0] * xk0 + wk[1] * xk1 + wk[2] * xk2 + wk[3] * rk);
        const float v = siluf_(wv[0] * xv0 + wv[1] * xv1 + wv[2] * xv2 + wv[3] * rv);
        xq0 = xq1; xq1 = xq2; xq2 = rq; xk0 = xk1; xk1 = xk2; xk2 = rk; xv0 = xv1; xv1 = xv2; xv2 = rv;
        q = q * rsqrtf(wave_sum(q * q) + EPS) * 0.125f;
        k = k * rsqrtf(wave_sum(k * k) + EPS);
        const float beta = sigmoidf_(bin);
        const float eg = expf(A * softplusf_(ain + dt_bias));
        scr[lane] = q; scr[64 + lane] = k;
        LDS_WAIT();
        float ks = 0.f;
#pragma unroll
        for (int d = 0; d < 64; ++d) { S[d] *= eg; ks += scr[64 + d] * S[d]; }
        const float vn = beta * (v - ks);
        float o = 0.f;
#pragma unroll
        for (int d = 0; d < 64; ++d) { S[d] += scr[64 + d] * vn; o += scr[d] * S[d]; }
        LDS_WAIT();
        const float ms = wave_sum(o * o) * (1.f / 64.f);
        Y[(size_t)t * D + 256 + h * 64 + lane] = (bf16)f2bf(o * rsqrtf(ms + EPS) * gn * siluf_(gate));
    }
}
__device__ __forceinline__ void task_gla(LAS float* scr, const bf16* P, const float* w_gk  , const float* b_gk, const float* norm_g, bf16* Y, int h, int lane) {
    float S[32];
#pragma unroll
    for (int d = 0; d < 32; ++d) S[d] = 0.f;
    const float gn = norm_g[lane];
    const int dl = lane & 31;
    float wg[16];
#pragma unroll
    for (int r = 0; r < 16; ++r) wg[r] = w_gk[r * 128 + h * 32 + dl];
    const float bg = b_gk[h * 32 + dl];
    const float qs = 0.17677669529663687f;
    for (int t = 0; t < L; ++t) {
        const bf16* pr = P + (size_t)t * NP;
        float z = bg;
#pragma unroll
        for (int r = 0; r < 16; ++r) z += bf2f(pr[C_GCODE + r]) * wg[r];
        const float gk = -softplusf_(-z) * (1.f / 16.f);
        const float qd = bf2f(pr[C_GQ + h * 32 + dl]) * qs, kd = bf2f(pr[C_GK + h * 32 + dl]);
        const float v = bf2f(pr[C_GV + h * 64 + lane]), gate = bf2f(pr[C_GG + h * 64 + lane]);
        if (lane < 32) { scr[dl] = expf(gk); scr[32 + dl] = qd; scr[64 + dl] = kd; }
        LDS_WAIT();
        float o = 0.f;
#pragma unroll
        for (int d = 0; d < 32; ++d) { S[d] = scr[d] * S[d] + scr[64 + d] * v; o += scr[32 + d] * S[d]; }
        LDS_WAIT();
        const float ms = wave_sum(o * o) * (1.f / 64.f);
        Y[(size_t)t * D + 768 + h * 64 + lane] = (bf16)f2bf(o * rsqrtf(ms + EPS) * gn * siluf_(gate));
    }
}
__device__ __forceinline__ void task_s5(bf16* P, const float* coef, const float* c_re, const float* c_im, const float* dd, int g, int lane) {
    const int i = g * 64 + lane;
    const float ar = coef[i], ai = coef[1024 + i];
    float br[16], bi[16], cr[16], ci[16];
#pragma unroll
    for (int h = 0; h < 16; ++h) { br[h] = coef[2048 + i * 16 + h]; bi[h] = coef[2048 + 16384 + i * 16 + h]; cr[h] = c_re[(g * 16 + h) * 64 + lane]; ci[h] = c_im[(g * 16 + h) * 64 + lane]; }
    const float dmy = dd[g * 16 + (lane & 15)];
    float sr = 0.f, si = 0.f;
    for (int t = 0; t < L; ++t) {
        bf16* ur = P + (size_t)t * NP + C_SU + g * 16;
        float u[16];
#pragma unroll
        for (int h = 0; h < 16; ++h) u[h] = bf2f(ur[h]);
        float xr = 0.f, xi = 0.f;
#pragma unroll
        for (int h = 0; h < 16; ++h) { xr += br[h] * u[h]; xi += bi[h] * u[h]; }
        const float nr = ar * sr - ai * si + xr, ni = ar * si + ai * sr + xi;
        sr = nr; si = ni;
        float mine = 0.f, umine = 0.f;
#pragma unroll
        for (int h = 0; h < 16; ++h) { const float tot = wave_sum(cr[h] * sr - ci[h] * si); if ((lane & 15) == h) { mine = tot; umine = u[h]; } }
        if (lane < 16) ur[lane] = (bf16)f2bf(geluf_(mine + dmy * umine));
    }
}

__global__ void __launch_bounds__(NWAVES * 64, 2) hymba_fwd(Args args) {
    extern __shared__ __attribute__((aligned(16))) unsigned char lds[];
    LAS unsigned char* ldsb0 = (LAS unsigned char*)lds;
    volatile LAS unsigned* MISC = (volatile LAS unsigned*)(ldsb0 + MISC_OFF);
    const int tid = threadIdx.x, lane = tid & 63, wave = __builtin_amdgcn_readfirstlane(tid >> 6);
    const int G = gridDim.x, bx = blockIdx.x;
    unsigned char* ws = args.ws;
    gu32* ctl = (gu32*)(ws + WS_CTL);
    for (int u = tid; u < (LDS_BYTES - LDSCTL_OFF) / 4; u += NWAVES * 64) ((LAS unsigned*)(ldsb0 + LDSCTL_OFF))[u] = 0u;
    __syncthreads();
    XcdBarrier bar = xcd_barrier_post((unsigned*)(ctl + CW_BAR), MISC + 8);
#define GRID_BAR() xcd_barrier(bar)
    if (tid == 0) {
#pragma unroll
        for (int k = 0; k < 23; ++k) ((LAS unsigned long long*)(ldsb0 + ARGS_OFF))[k] = (unsigned long long)args.in[k];
        ((LAS unsigned long long*)(ldsb0 + ARGS_OFF))[23] = (unsigned long long)args.out; ((LAS unsigned long long*)(ldsb0 + ARGS_OFF))[24] = (unsigned long long)args.ws;
    }
    __syncthreads();
#define ARGU64(k) ({ const unsigned long long v_ = *(volatile LAS unsigned long long*)(ldsb + ARGS_OFF + 8 * (k)); \
        ((unsigned long long)(unsigned)__builtin_amdgcn_readfirstlane((int)(unsigned)(v_ >> 32)) << 32) | (unsigned)__builtin_amdgcn_readfirstlane((int)(unsigned)v_); })
#define ARGF(k) ((const float*)ARGU64(k))
#define x_in ARGF(0)
#define norm_pre ARGF(1)
#define norm_post ARGF(2)
#define w_in ARGF(3)
#define w_out ARGF(4)
#define ret_norm ARGF(5)
#define dn_conv ARGF(6)
#define dn_a_log ARGF(7)
#define dn_dt_bias ARGF(8)
#define dn_norm ARGF(9)
#define s5_lam_re ARGF(10)
#define s5_lam_im ARGF(11)
#define s5_b_re ARGF(12)
#define s5_b_im ARGF(13)
#define s5_c_re ARGF(14)
#define s5_c_im ARGF(15)
#define s5_d ARGF(16)
#define s5_log_dt ARGF(17)
#define s5_w_glu ARGF(18)
#define s5_b_glu ARGF(19)
#define gla_w_gk ARGF(20)
#define gla_b_gk ARGF(21)
#define gla_norm ARGF(22)
#define X ((float*)ARGU64(23))
#define WSB ((unsigned char*)ARGU64(24))
#define TAB ((f32x2v*)(ws + WS_TAB))
#define COEF ((float*)(ws + WS_COEF))
#define WGLU ((bf16*)(ws + WS_WGLU))
#define WOUT ((bf16*)(ws + WS_WOUT))
#define WIN ((bf16*)(ws + WS_WIN))
#define HY ((bf16*)(ws + WS_HY))
#define P ((bf16*)(ws + WS_P))
#define O32 ((float*)(ws + WS_P))
    const int NGW = G * NWAVES, NGT = G * NWAVES * 64;

#define PHASE_IDS() LAS unsigned char* ldsb_p = ldsb0; asm volatile("" : "+s"(ldsb_p)); LAS unsigned char* const ldsb = ldsb_p; \
        int lane_p, bx_p = blockIdx.x; asm volatile("v_mbcnt_lo_u32_b32 %0, -1, 0\n\tv_mbcnt_hi_u32_b32 %0, -1, %0" : "=v"(lane_p)); asm volatile("" : "+s"(bx_p)); \
        const int lane = lane_p, tid = wave * 64 + lane_p, bx = bx_p, gw = bx * NWAVES + wave, gt = bx * (NWAVES * 64) + tid; unsigned char* const ws = WSB; \
        (void)lane; (void)tid; (void)bx; (void)gw; (void)gt; (void)ws
#define CONVERT_WEIGHTS(wl_) do { \
        LAS float* scr_ = (LAS float*)(ldsb + wave * 16384); const float* wi_ = w_in; const float* wo_ = w_out; const float* wg_ = s5_w_glu; \
        constexpr int I_IN = 16 * 105, I_OUT = 16 * 32, I_GLU = 4 * 8, I_L = I_IN + I_OUT + I_GLU; \
        for (int it_ = gw; it_ < I_L; it_ += NGW) { int r_ = it_; \
            if (r_ < I_IN) { p0_transpose_item(wi_ + (size_t)(wl_) * D * NC, D, NC, WIN, scr_, r_, lane); continue; } r_ -= I_IN; \
            if (r_ < I_OUT) { p0_transpose_item(wo_ + (size_t)(wl_) * D * D, D, D, WOUT, scr_, r_, lane); continue; } r_ -= I_OUT; \
            p0_transpose_item(wg_ + (size_t)(wl_) * 65536, 256, 256, WGLU, scr_, r_, lane); } \
    } while (0)
    {
        PHASE_IDS();
        CONVERT_WEIGHTS(0);
        for (int it = gt; it < 224 * 128; it += NGT) ((GAS v4u*)(WIN + (size_t)3360 * D))[it] = (v4u){0u, 0u, 0u, 0u};
        const float* xin_ = x_in; float* xout_ = X; const float* npre_ = norm_pre;
        for (int m = gw; m < M; m += NGW) {
            const GAS f32x4* xr = (const GAS f32x4*)(xin_ + (size_t)m * D) + lane; GAS f32x4* xo = (GAS f32x4*)(xout_ + (size_t)m * D) + lane;
            f32x4 v[4]; float s = 0.f;
#pragma unroll
            for (int j = 0; j < 4; ++j) { v[j] = xr[64 * j]; xo[64 * j] = v[j]; s += (v[j].x * v[j].x + v[j].y * v[j].y) + (v[j].z * v[j].z + v[j].w * v[j].w); }
            const float rstd = rsqrtf(wave_sum(s) * (1.f / D) + EPS);
            GAS unsigned long long* o8 = (GAS unsigned long long*)(HY + (size_t)m * D) + lane;
#pragma unroll
            for (int j = 0; j < 4; ++j) { const f32x4 gg = ((const GAS f32x4*)npre_)[lane + 64 * j];
                o8[64 * j] = (unsigned long long)pk2(v[j].x * rstd * gg.x, v[j].y * rstd * gg.y) | ((unsigned long long)pk2(v[j].z * rstd * gg.z, v[j].w * rstd * gg.w) << 32); }
        }
        for (int it = gt; it < L * 32; it += NGT) { const int t = it >> 5, i = it & 31; const float inv = powf(10000.f, -(float)(2 * i) / 64.f); float sn, cs; sincosf((float)t * inv, &sn, &cs); TAB[it] = (f32x2v){cs, sn}; }
        const float* ldt_ = s5_log_dt; const float* lre_ = s5_lam_re; const float* lim_ = s5_lam_im; const float* bre_ = s5_b_re; const float* bim_ = s5_b_im;
        for (int it = gt; it < DEPTH * 1024; it += NGT) {
            const int l = it >> 10, i = it & 1023, g = i >> 6;
            const float dt = expf(ldt_[l * 16 + g]);
            const float lr = lre_[it], li = lim_[it];
            const float mag = expf(lr * dt), ang = li * dt;
            const float ar = mag * cosf(ang), ai = mag * sinf(ang);
            const float den = lr * lr + li * li, nr = ar - 1.f, ni = ai;
            const float cr = (nr * lr + ni * li) / den, ci = (ni * lr - nr * li) / den;
            float* cf = COEF + (size_t)l * COEF_STRIDE;
            cf[i] = ar; cf[1024 + i] = ai;
            for (int h = 0; h < 16; ++h) { const float br = bre_[(size_t)it * 16 + h], bi = bim_[(size_t)it * 16 + h];
                cf[2048 + i * 16 + h] = cr * br - ci * bi; cf[2048 + 16384 + i * 16 + h] = cr * bi + ci * br; }
        }
    }
    GRID_BAR();

#pragma nounroll
    for (int l = 0; l < DEPTH; ++l) {
        {
            PHASE_IDS();
            pg8::Gemm g{HY, WIN, M, NP, D, D, D}; pg8::StaticOrder S; S.init(M, NP, G, bx);
            pg8::EpiStoreBf16 E{P, NP};
            pg8::gemm_phase<pg8::EpiStoreBf16, pg8::StaticOrder, true, true, D, D, D>(ldsb, g, S, E, tid);
        }
        GRID_BAR();
        {
            PHASE_IDS();
            LAS unsigned char* wl = ldsb + wave * mx::WLDS;
            for (int it = gw; it < 2048; it += NGW) {
                const int ii = it & 1023, bh = ii >> 7, n = ii & 127, b = bh >> 2, h = bh & 3;
                bf16* Pt = P + (size_t)(b * L + n * 64) * NP;
                if (it < 1024) { if (CH_RET) ret_A(wl, Pt, TAB, n * 64, h, (float*)(ws + WS_RET_KV) + (size_t)ii * 4096, lane); }
                else if (CH_GLA) gla_A(wl, Pt, gla_w_gk + (size_t)l * 16 * 128, gla_b_gk + l * 128, h, (float*)(ws + WS_GLA_KV) + (size_t)ii * 2048, (float*)(ws + WS_GLA_DEC) + (size_t)ii * 32, lane);
            }
            if (wave == 0) {
                LAS float* scr = (LAS float*)wl;
                if (!CH_RET && bx < 8) { const int b = bx >> 2, h = bx & 3; task_ret(scr, P + (size_t)b * L * NP, TAB, ret_norm + l * 64, HY + (size_t)b * L * D, h, lane); }
                else if (!CH_GLA && bx >= 16 && bx < 24) { const int b = (bx - 16) >> 2, h = bx & 3; task_gla(scr, P + (size_t)b * L * NP, gla_w_gk + (size_t)l * 16 * 128, gla_b_gk + l * 128, gla_norm + l * 64, HY + (size_t)b * L * D, h, lane); }
                else if (bx >= 8 && bx < 16) { const int b = (bx - 8) >> 2, h = bx & 3; task_dn(scr, P + (size_t)b * L * NP, dn_conv + (size_t)l * 4 * 768, dn_a_log[l * 4 + h], dn_dt_bias[l * 4 + h], dn_norm + l * 64, HY + (size_t)b * L * D, h, lane); }
                else if (bx >= 24 && bx < 56) { const int b = (bx - 24) >> 4, g = (bx - 24) & 15; task_s5(P + (size_t)b * L * NP, COEF + (size_t)l * COEF_STRIDE, s5_c_re + (size_t)l * 16384, s5_c_im + (size_t)l * 16384, s5_d + l * 256, g, lane); }
            }
        }
        GRID_BAR();
        {
            PHASE_IDS();
            if (wave == 0) {
                if (CH_RET && bx < 64) { const int bh = bx >> 3, sub = bx & 7; const float g64 = exp2f(64.f * log2f(1.f - exp2f(-5.f - (float)(bh & 3))));
                    la_scan<2>((const float*)(ws + WS_RET_KV) + (size_t)bh * 128 * 4096, (bf16*)(ws + WS_RET_RP) + (size_t)bh * 128 * 4096, nullptr, g64, sub, lane); }
                else if (CH_GLA && bx >= 64 && bx < 96) { const int bh = (bx - 64) >> 2, sub = (bx - 64) & 3;
                    la_scan<1>((const float*)(ws + WS_GLA_KV) + (size_t)bh * 128 * 2048, (bf16*)(ws + WS_GLA_RP) + (size_t)bh * 128 * 2048, (const float*)(ws + WS_GLA_DEC) + (size_t)bh * 128 * 32, 0.f, sub, lane); }
            }
        }
        GRID_BAR();
        {
            PHASE_IDS();
            LAS unsigned char* wl = ldsb + wave * mx::WLDS;
            for (int it = gw; it < 2048; it += NGW) {
                const int ii = it & 1023, bh = ii >> 7, n = ii & 127, b = bh >> 2, h = bh & 3;
                const size_t t0 = (size_t)(b * L + n * 64);
                const bf16* Pt = P + t0 * NP;
                if (it < 1024) { if (CH_RET) mx::la_out<64>(wl, Pt + C_RQ + h * 64, Pt + C_RK + h * 64, NP, Pt + C_RV + h * 64, Pt + C_RG + h * 64, NP,
                                              (const bf16*)(ws + WS_RET_RP) + (size_t)ii * 4096, ret_norm + l * 64, HY + t0 * D + 0 + h * 64, D, lane); }
                else if (CH_GLA) mx::la_out<32>(wl, Pt + C_GQ + h * 32, Pt + C_GK + h * 32, NP, Pt + C_GV + h * 64, Pt + C_GG + h * 64, NP,
                                    (const bf16*)(ws + WS_GLA_RP) + (size_t)ii * 2048, gla_norm + l * 64, HY + t0 * D + 768 + h * 64, D, lane);
            }
        }
        GRID_BAR();
        {
            PHASE_IDS();
            pg8::Gemm g{P + C_SU, WGLU, M, 256, 256, NP, 256}; pg8::StaticOrder S; S.init(M, 256, G, bx);
            pg8::EpiGlu E{P + C_SU, P + C_SG, NP, s5_b_glu + l * 256, HY + 512, D};
            pg8::gemm_phase<pg8::EpiGlu, pg8::StaticOrder, true, true, 256, NP, 256>(ldsb, g, S, E, tid);
        }
        GRID_BAR();
        {
            PHASE_IDS();
            pg8::Gemm g{HY, WOUT, M, D, D, D, D}; pg8::StaticOrder S; S.init(M, D, G, bx);
            pg8::EpiStoreF32 E{O32, D};
            pg8::gemm_phase<pg8::EpiStoreF32, pg8::StaticOrder, true, true, D, D, D>(ldsb, g, S, E, tid);
        }
        GRID_BAR();
        {
            PHASE_IDS();
            if (l + 1 < DEPTH) CONVERT_WEIGHTS(l + 1);
            float* xout_ = X; const float* npost_ = norm_post + l * D; const float* npre_ = norm_pre + (l + 1 < DEPTH ? l + 1 : l) * D;
            for (int m = gw; m < M; m += NGW) {
                const GAS f32x4* orow = (const GAS f32x4*)(O32 + (size_t)m * D) + lane; GAS f32x4* xr = (GAS f32x4*)(xout_ + (size_t)m * D) + lane;
                f32x4 o[4], xv[4]; float s = 0.f;
#pragma unroll
                for (int j = 0; j < 4; ++j) { o[j] = orow[64 * j]; xv[j] = xr[64 * j]; s += (o[j].x * o[j].x + o[j].y * o[j].y) + (o[j].z * o[j].z + o[j].w * o[j].w); }
                const float rstd = rsqrtf(wave_sum(s) * (1.f / D) + EPS);
                float s2 = 0.f;
#pragma unroll
                for (int j = 0; j < 4; ++j) { const f32x4 gg = ((const GAS f32x4*)npost_)[lane + 64 * j];
                    xv[j].x += o[j].x * rstd * gg.x; xv[j].y += o[j].y * rstd * gg.y; xv[j].z += o[j].z * rstd * gg.z; xv[j].w += o[j].w * rstd * gg.w;
                    xr[64 * j] = xv[j]; s2 += (xv[j].x * xv[j].x + xv[j].y * xv[j].y) + (xv[j].z * xv[j].z + xv[j].w * xv[j].w); }
                if (l + 1 < DEPTH) {
                    const float r2 = rsqrtf(wave_sum(s2) * (1.f / D) + EPS);
                    GAS unsigned long long* o8 = (GAS unsigned long long*)(HY + (size_t)m * D) + lane;
#pragma unroll
                    for (int j = 0; j < 4; ++j) { const f32x4 gg = ((const GAS f32x4*)npre_)[lane + 64 * j];
                        o8[64 * j] = (unsigned long long)pk2(xv[j].x * r2 * gg.x, xv[j].y * r2 * gg.y) | ((unsigned long long)pk2(xv[j].z * r2 * gg.z, xv[j].w * r2 * gg.w) << 32); }
                }
            }
        }
        if (l + 1 < DEPTH) GRID_BAR();
    }
}

extern "C" void kernel_launch(void* const* d_in, const int* in_sizes, int n_in, void* d_out, int out_size, void* d_ws, size_t ws_size, hipStream_t stream) {
    static int grid = 0;
    if (grid == 0) {
        if (n_in != 23 || out_size != M * D || ws_size < WS_END) { fprintf(stderr, "kernel_launch: unexpected shapes (n_in %d out %d ws %zu)\n", n_in, out_size, ws_size); grid = -1; return; }
        int dev = 0, cus = 0, per_cu = 0;
        if (hipGetDevice(&dev) != hipSuccess || hipDeviceGetAttribute(&cus, hipDeviceAttributeMultiprocessorCount, dev) != hipSuccess) { grid = -1; return; }
        if (hipFuncSetAttribute((const void*)hymba_fwd, hipFuncAttributeMaxDynamicSharedMemorySize, LDS_BYTES) != hipSuccess) { fprintf(stderr, "kernel_launch: hipFuncSetAttribute failed\n"); grid = -1; return; }
        if (hipOccupancyMaxActiveBlocksPerMultiprocessor(&per_cu, (const void*)hymba_fwd, NWAVES * 64, LDS_BYTES) != hipSuccess || per_cu < 1) { fprintf(stderr, "kernel_launch: occupancy query says %d blocks/CU\n", per_cu); grid = -1; return; }
        grid = cus;
    }
    if (grid < 0) return;
    (void)hipMemsetAsync((char*)d_ws + WS_CTL, 0, CTL_ZERO_BYTES, stream);
    Args a{};
    for (int i = 0; i < 23; ++i) a.in[i] = (const float*)d_in[i];
    a.out = (float*)d_out; a.ws = (unsigned char*)d_ws;
    void* kargs[] = {&a};
    const hipError_t e = hipLaunchCooperativeKernel((const void*)hymba_fwd, dim3(grid), dim3(NWAVES * 64), kargs, LDS_BYTES, stream);
    if (e != hipSuccess) fprintf(stderr, "cooperative launch failed: %s (grid %d)\n", hipGetErrorString(e), grid);
}
```

```cpp
#include <hip/hip_runtime.h>
#include <cstdio>
#include <cstdint>
#include <math.h>
#ifndef CH_RET
#define CH_RET 1
#endif
#ifndef CH_GLA
#define CH_GLA 1
#endif
#ifndef CH_S5
#define CH_S5 1
#endif
#ifndef CH_DN
#define CH_DN 1
#endif
namespace pg8 {
#define PG8_LAS __attribute__((address_space(3)))
typedef unsigned short bf16_t;
typedef short bf16x8 __attribute__((ext_vector_type(8)));
typedef float f32x4 __attribute__((ext_vector_type(4)));
typedef unsigned u32x4 __attribute__((ext_vector_type(4)));
constexpr int BM = 256, BK = 64, HALF = 128, HTB = HALF * BK * 2  , STAGE_BYTES = 8 * HTB, NXCD = 8, WGM = 8;

__host__ __device__ __forceinline__ int lds_byte(int r, int c) { const int st = (r >> 4) * 2 + (c >> 5), rr = r & 15, cc = c & 31, ob = rr * 64 + cc * 2; return st * 1024 + (ob ^ (((ob >> 9) & 1) << 5)); }
__host__ __device__ __forceinline__ void stage_rc(int b, int& R, int& C) { const int st = b / 1024, sb = b % 1024, swz = sb ^ (((sb >> 9) & 1) << 5); R = (st >> 1) * 16 + swz / 64; C = (st & 1) * 32 + (swz % 64) / 2; }
__host__ __device__ __forceinline__ int perm32(int rho) { const int n = rho >> 4, i = rho & 15; return 8 * (i >> 2) + 4 * n + (i & 3); }

struct Unit { int pm, pn; };
struct Gemm { const bf16_t* A; const bf16_t* Bt; int M, N, K, lda, ldb; };

struct StaticOrder {
    int nM, nN, nwg, G, c;
    __host__ __device__ void init(int M, int N, int G_, int c_) { nM = M / BM; nN = N / BM; nwg = nM * nN; G = G_; c = c_; }
    __host__ __device__ bool next(int i, Unit& u) const {
        const long L = (long)i * G + c; if (L >= nwg) return false;
        int wgid = (int)L; { const int q = nwg / NXCD, r = nwg % NXCD, xcd = wgid % NXCD, off = wgid / NXCD; wgid = (xcd < r ? xcd * (q + 1) : r * (q + 1) + (xcd - r) * q) + off; }
        const int nig = WGM * nN, gid = wgid / nig, fm = gid * WGM, gsz = (nM - fm) < WGM ? (nM - fm) : WGM;
        u.pm = fm + ((wgid % nig) % gsz); u.pn = (wgid % nig) / gsz; return true;
    }
    __device__ __forceinline__ void a_ready(const Unit&) const {}
    __device__ __forceinline__ void done(const Unit&) const {}
};

__device__ __forceinline__ unsigned cvt_pk_bf16(float lo, float hi) { unsigned r; asm volatile("v_cvt_pk_bf16_f32 %0, %1, %2" : "=v"(r) : "v"(lo), "v"(hi)); return r; }
__device__ __forceinline__ float bf_lo(unsigned w) { return __builtin_bit_cast(float, w << 16); }
__device__ __forceinline__ float bf_hi(unsigned w) { return __builtin_bit_cast(float, w & 0xffff0000u); }
struct EpiStoreBf16 {
    static constexpr bool PERM = true, AFTER_DRAIN = false;
    bf16_t* O; int ldc;
    __device__ __forceinline__ void operator()(const f32x4 (&acc)[2][2][4][2], const Unit& u, int wr, int wc, int fr, int fq) const {
        const int row0 = u.pm * BM + wr * 64 + fr, col0 = u.pn * BM + wc * 32 + 8 * fq;
#pragma unroll
        for (int ai = 0; ai < 2; ++ai)
#pragma unroll
            for (int m = 0; m < 4; ++m) { bf16_t* rowp = O + (size_t)(row0 + ai * HALF + m * 16) * ldc + col0;
#pragma unroll
                for (int bj = 0; bj < 2; ++bj) { const f32x4 v0 = acc[ai][bj][m][0], v1 = acc[ai][bj][m][1];
                    u32x4 w; w.x = cvt_pk_bf16(v0[0], v0[1]); w.y = cvt_pk_bf16(v0[2], v0[3]); w.z = cvt_pk_bf16(v1[0], v1[1]); w.w = cvt_pk_bf16(v1[2], v1[3]);
                    *(u32x4*)(rowp + bj * HALF) = w; } }
    }
};
struct EpiStoreF32 {
    static constexpr bool PERM = false, AFTER_DRAIN = false;
    float* C; int ldc;
    __device__ __forceinline__ void operator()(const f32x4 (&acc)[2][2][4][2], const Unit& u, int wr, int wc, int fr, int fq) const {
        const int row0 = u.pm * BM + wr * 64 + fr, col0 = u.pn * BM + wc * 32 + 4 * fq;
#pragma unroll
        for (int ai = 0; ai < 2; ++ai)
#pragma unroll
            for (int m = 0; m < 4; ++m) { float* rowp = C + (size_t)(row0 + ai * HALF + m * 16) * ldc + col0;
#pragma unroll
                for (int bj = 0; bj < 2; ++bj)
#pragma unroll
                    for (int n = 0; n < 2; ++n) *(f32x4*)(rowp + bj * HALF + n * 16) = acc[ai][bj][m][n]; }
    }
};
struct EpiGlu {
    static constexpr bool PERM = true, AFTER_DRAIN = false;
    const bf16_t* YG; const bf16_t* SG; int ldp; const float* bias; bf16_t* O; int ldo;
    __device__ __forceinline__ void operator()(const f32x4 (&acc)[2][2][4][2], const Unit& u, int wr, int wc, int fr, int fq) const {
        const int row0 = u.pm * BM + wr * 64 + fr, col0 = u.pn * BM + wc * 32 + 8 * fq;
#pragma unroll
        for (int ai = 0; ai < 2; ++ai)
#pragma unroll
            for (int m = 0; m < 4; ++m) { const size_t r = (size_t)(row0 + ai * HALF + m * 16);
#pragma unroll
                for (int bj = 0; bj < 2; ++bj) { const int c = col0 + bj * HALF;
                    const u32x4 yw = *(const u32x4*)(YG + r * ldp + c), gw = *(const u32x4*)(SG + r * ldp + c);
                    const f32x4 b0 = *(const f32x4*)(bias + c), b1 = *(const f32x4*)(bias + c + 4);
                    const f32x4 v0 = acc[ai][bj][m][0] + b0, v1 = acc[ai][bj][m][1] + b1;
                    float z[8] = {v0[0], v0[1], v0[2], v0[3], v1[0], v1[1], v1[2], v1[3]};
                    float yv[8] = {bf_lo(yw.x), bf_hi(yw.x), bf_lo(yw.y), bf_hi(yw.y), bf_lo(yw.z), bf_hi(yw.z), bf_lo(yw.w), bf_hi(yw.w)};
                    float gv[8] = {bf_lo(gw.x), bf_hi(gw.x), bf_lo(gw.y), bf_hi(gw.y), bf_lo(gw.z), bf_hi(gw.z), bf_lo(gw.w), bf_hi(gw.w)};
                    float o[8];
#pragma unroll
                    for (int e = 0; e < 8; ++e) { const float sz = 1.f / (1.f + __expf(-z[e])), sg = gv[e] / (1.f + __expf(-gv[e])); o[e] = yv[e] * sz * sg; }
                    u32x4 w; w.x = cvt_pk_bf16(o[0], o[1]); w.y = cvt_pk_bf16(o[2], o[3]); w.z = cvt_pk_bf16(o[4], o[5]); w.w = cvt_pk_bf16(o[6], o[7]);
                    *(u32x4*)(O + r * ldo + c) = w; } }
    }
};

template <class Epi, class Sched, bool ALIGN_EPI, bool SP2, int KK, int LDA, int LDB>
__device__ __forceinline__ void gemm_phase(PG8_LAS unsigned char* lds, const Gemm g, const Sched& S, const Epi& E, int tid_in) {
    int tid_ = tid_in; asm volatile("" : "+v"(tid_));
    const int tid = tid_, wid = __builtin_amdgcn_readfirstlane(tid >> 6), lane = tid & 63, wr = wid >> 2, wc = wid & 3, fr = lane & 15, fq = lane >> 4;
    constexpr int K = KK, nt = K / BK;
    unsigned voffA[2], voffB[2];
#pragma unroll
    for (int i = 0; i < 2; ++i) { int R, C; stage_rc(tid * 16 + i * 8192, R, C); const int Rb = Epi::PERM ? ((R & ~31) + perm32(R & 31)) : R;
        voffA[i] = (unsigned)(R * LDA + C) * 2u; voffB[i] = (unsigned)(Rb * LDB + C) * 2u; }
    constexpr size_t kstep = (size_t)(BK * 2);
    constexpr size_t hstepA = (size_t)HALF * LDA * 2, hstepB = (size_t)HALF * LDB * 2;
    constexpr size_t tstepA = 2 * hstepA, tstepB = 2 * hstepB;
    const unsigned ldsw = (unsigned)wid * 1024u;
    const int aoff = lds_byte(wr * 64 + fr, fq * 8), boff = lds_byte(wc * 32 + fr, fq * 8);
#define PG8_SA(b, h) (((b) * 2 + (h)) * HTB)
#define PG8_SB(b, h) ((4 + (b) * 2 + (h)) * HTB)
#define PG8_STAGE(bufoff, gbase, voff) do { _Pragma("unroll") for (int _i = 0; _i < 2; ++_i) \
        __builtin_amdgcn_global_load_lds((const unsigned*)((const char*)(gbase) + (voff)[_i]), (PG8_LAS unsigned*)(lds + (bufoff) + ldsw + _i * 8192), 16, 0, 0); } while (0)
#define PG8_LDA(dst, b, h) do { _Pragma("unroll") for (int m = 0; m < 4; ++m) _Pragma("unroll") for (int k = 0; k < 2; ++k) dst[m][k] = *(const PG8_LAS bf16x8*)(lds + PG8_SA(b, h) + aoff + m * 2048 + k * 1024); } while (0)
#define PG8_LDB(dst, b, h) do { _Pragma("unroll") for (int n = 0; n < 2; ++n) _Pragma("unroll") for (int k = 0; k < 2; ++k) dst[n][k] = *(const PG8_LAS bf16x8*)(lds + PG8_SB(b, h) + boff + n * 2048 + k * 1024); } while (0)
#define PG8_MMA(ai, bj, At, Bt) do { __builtin_amdgcn_s_setprio(1); _Pragma("unroll") for (int m = 0; m < 4; ++m) _Pragma("unroll") for (int n = 0; n < 2; ++n) _Pragma("unroll") for (int k = 0; k < 2; ++k) \
        acc[ai][bj][m][n] = __builtin_amdgcn_mfma_f32_16x16x32_bf16(Bt[n][k], At[m][k], acc[ai][bj][m][n], 0, 0, 0); __builtin_amdgcn_s_setprio(0); } while (0)
#define PG8_WAIT_V(n) asm volatile("s_waitcnt vmcnt(" #n ")" ::: "memory")
#define PG8_WAIT_L(n) asm volatile("s_waitcnt lgkmcnt(" #n ")" ::: "memory")
#define PG8_BAR __builtin_amdgcn_s_barrier()
#define PG8_SCHED __builtin_amdgcn_sched_barrier(0)
    Unit cur, nxt; int ui = 0;
    if (!S.next(0, cur)) return;
    f32x4 acc[2][2][4][2];
#pragma unroll
    for (int a = 0; a < 2; ++a)
#pragma unroll
        for (int b = 0; b < 2; ++b)
#pragma unroll
            for (int m = 0; m < 4; ++m)
#pragma unroll
                for (int n = 0; n < 2; ++n) acc[a][b][m][n] = (f32x4){0.f, 0.f, 0.f, 0.f};
    bf16x8 At[4][2], B0[2][2], B1[2][2];
    const char* cA = (const char*)g.A + (size_t)cur.pm * tstepA; const char* cB = (const char*)g.Bt + (size_t)cur.pn * tstepB;
    S.a_ready(cur);
    if constexpr (SP2) {
        PG8_STAGE(PG8_SB(0, 0), cB, voffB); PG8_STAGE(PG8_SB(0, 1), cB + hstepB, voffB); PG8_STAGE(PG8_SA(0, 0), cA, voffA); PG8_STAGE(PG8_SA(0, 1), cA + hstepA, voffA);
        if (wr == 1) PG8_BAR;
        PG8_WAIT_V(2); PG8_BAR;
        PG8_STAGE(PG8_SB(1, 0), cB + kstep, voffB); PG8_STAGE(PG8_SA(1, 0), cA + kstep, voffA); PG8_STAGE(PG8_SB(1, 1), cB + hstepB + kstep, voffB);
        PG8_WAIT_V(6); PG8_BAR;
    } else {
        PG8_STAGE(PG8_SB(0, 0), cB, voffB); PG8_STAGE(PG8_SA(0, 0), cA, voffA); PG8_STAGE(PG8_SB(0, 1), cB + hstepB, voffB); PG8_STAGE(PG8_SA(0, 1), cA + hstepA, voffA);
        if (wr == 1) PG8_BAR;
        PG8_WAIT_V(4); PG8_BAR;
        PG8_STAGE(PG8_SB(1, 0), cB + kstep, voffB); PG8_STAGE(PG8_SA(1, 0), cA + kstep, voffA); PG8_STAGE(PG8_SB(1, 1), cB + hstepB + kstep, voffB);
        PG8_WAIT_V(6); PG8_BAR;
    }
    for (;;) {
        const bool has_next = S.next(ui + 1, nxt);
        const char* nA = has_next ? (const char*)g.A + (size_t)nxt.pm * tstepA : cA; const char* nB = has_next ? (const char*)g.Bt + (size_t)nxt.pn * tstepB : cB;
        for (int t = 0; t < nt; t += 2) {
            const bool last = (t == nt - 2);
            const char* a1 = cA + (size_t)(t + 1) * kstep;
            const char* a2 = last ? nA : cA + (size_t)(t + 2) * kstep; const char* b2 = last ? nB : cB + (size_t)(t + 2) * kstep;
            const char* a3 = a2 + kstep; const char* b3 = b2 + kstep;
            if (last && has_next) S.a_ready(nxt);
            if constexpr (SP2) {
            PG8_LDB(B0, 0, 0); PG8_LDB(B1, 0, 1); PG8_SCHED; PG8_LDA(At, 0, 0); PG8_STAGE(PG8_SA(1, 1), a1 + hstepA, voffA);
            PG8_WAIT_V(8); PG8_WAIT_L(0); PG8_BAR; PG8_MMA(0, 0, At, B0); PG8_MMA(0, 1, At, B1); PG8_BAR; PG8_SCHED;
            PG8_LDA(At, 0, 1); PG8_STAGE(PG8_SB(0, 0), b2, voffB); PG8_STAGE(PG8_SB(0, 1), b2 + hstepB, voffB); PG8_STAGE(PG8_SA(0, 0), a2, voffA);
            PG8_WAIT_V(8); PG8_WAIT_L(0); PG8_BAR; PG8_MMA(1, 0, At, B0); PG8_MMA(1, 1, At, B1); PG8_BAR; PG8_SCHED;
            PG8_LDB(B0, 1, 0); PG8_LDB(B1, 1, 1); PG8_SCHED; PG8_LDA(At, 1, 0); PG8_STAGE(PG8_SA(0, 1), a2 + hstepA, voffA);
            PG8_WAIT_V(8); PG8_WAIT_L(0); PG8_BAR; PG8_MMA(0, 0, At, B0); PG8_MMA(0, 1, At, B1); PG8_BAR; PG8_SCHED;
            PG8_LDA(At, 1, 1); PG8_STAGE(PG8_SB(1, 0), b3, voffB); PG8_STAGE(PG8_SB(1, 1), b3 + hstepB, voffB); PG8_STAGE(PG8_SA(1, 0), a3, voffA);
            PG8_WAIT_V(8); PG8_WAIT_L(0); PG8_BAR; PG8_MMA(1, 0, At, B0); PG8_MMA(1, 1, At, B1); PG8_BAR; PG8_SCHED;
            } else {
            PG8_LDB(B0, 0, 0); PG8_SCHED; PG8_LDA(At, 0, 0); PG8_STAGE(PG8_SA(1, 1), a1 + hstepA, voffA);
            PG8_WAIT_L(8); PG8_BAR; PG8_WAIT_L(0); PG8_MMA(0, 0, At, B0); PG8_BAR; PG8_SCHED;
            PG8_LDB(B1, 0, 1); PG8_STAGE(PG8_SB(0, 0), b2, voffB);
            PG8_BAR; PG8_WAIT_L(0); PG8_MMA(0, 1, At, B1); PG8_BAR;
            PG8_LDA(At, 0, 1); PG8_STAGE(PG8_SA(0, 0), a2, voffA);
            PG8_BAR; PG8_WAIT_L(0); PG8_MMA(1, 0, At, B0); PG8_BAR; PG8_SCHED;
            PG8_STAGE(PG8_SB(0, 1), b2 + hstepB, voffB);
            PG8_WAIT_V(6); PG8_BAR; PG8_MMA(1, 1, At, B1); PG8_BAR;
            PG8_LDB(B0, 1, 0); PG8_SCHED; PG8_LDA(At, 1, 0); PG8_STAGE(PG8_SA(0, 1), a2 + hstepA, voffA);
            PG8_WAIT_L(8); PG8_BAR; PG8_WAIT_L(0); PG8_MMA(0, 0, At, B0); PG8_BAR; PG8_SCHED;
            PG8_LDB(B1, 1, 1); PG8_STAGE(PG8_SB(1, 0), b3, voffB);
            PG8_BAR; PG8_WAIT_L(0); PG8_MMA(0, 1, At, B1); PG8_BAR;
            PG8_LDA(At, 1, 1); PG8_STAGE(PG8_SA(1, 0), a3, voffA);
            PG8_BAR; PG8_WAIT_L(0); PG8_MMA(1, 0, At, B0); PG8_BAR; PG8_SCHED;
            PG8_STAGE(PG8_SB(1, 1), b3 + hstepB, voffB);
            PG8_WAIT_V(6); PG8_BAR; PG8_MMA(1, 1, At, B1); PG8_BAR;
            }
        }
        if constexpr (ALIGN_EPI) { if (wr == 0) PG8_BAR; }
        if constexpr (!Epi::AFTER_DRAIN) { E(acc, cur, wr, wc, fr, fq); S.done(cur); }
        if (!has_next) break;
#pragma unroll
        for (int a = 0; a < 2; ++a)
#pragma unroll
            for (int b = 0; b < 2; ++b)
#pragma unroll
                for (int m = 0; m < 4; ++m)
#pragma unroll
                    for (int n = 0; n < 2; ++n) acc[a][b][m][n] = (f32x4){0.f, 0.f, 0.f, 0.f};
        cur = nxt; cA = nA; cB = nB; ++ui;
        if constexpr (ALIGN_EPI) { if (wr == 1) PG8_BAR; }
    }
    PG8_WAIT_V(0);
    if constexpr (!ALIGN_EPI) { if (wr == 0) PG8_BAR; }
    PG8_BAR;
    if constexpr (Epi::AFTER_DRAIN) { E.fused(acc, cur, wr, wc, fr, fq, lds, wid, lane); S.done(cur); }
#undef PG8_SA
#undef PG8_SB
#undef PG8_STAGE
#undef PG8_LDA
#undef PG8_LDB
#undef PG8_MMA
#undef PG8_WAIT_V
#undef PG8_WAIT_L
#undef PG8_BAR
#undef PG8_SCHED
}
}

constexpr int NWAVES = 8;
constexpr int NB = 2, L = 8192, D = 1024, DEPTH = 4, NC = 3352, NP = 3584, M = NB * L;
constexpr int C_RQ = 0, C_RK = 256, C_RV = 512, C_RG = 768, C_DQKV = 1024, C_DBETA = 1792, C_DA = 1796, C_DG = 1800,
              C_SU = 2056, C_SG = 2312, C_GQ = 2568, C_GK = 2696, C_GV = 2824, C_GCODE = 3080, C_GG = 3096;
constexpr float EPS = 1e-6f;
constexpr size_t MiB = 1u << 20;
constexpr size_t WS_CTL = 0, CTL_ZERO_BYTES = 1 * MiB;
constexpr size_t WS_TAB = 1 * MiB;
constexpr size_t WS_COEF = 3 * MiB;
constexpr size_t WS_WGLU = 4 * MiB;
constexpr size_t WS_WOUT = 5 * MiB;
constexpr size_t WS_WIN = 7 * MiB;
constexpr size_t WS_HY = 14 * MiB;
constexpr size_t WS_P = 46 * MiB;
constexpr size_t WS_RET_KV = WS_HY;
constexpr size_t WS_GLA_KV = WS_HY + 16 * MiB;
constexpr size_t WS_S5_E = WS_HY + 24 * MiB;
constexpr size_t WS_RET_RP = 158 * MiB;
constexpr size_t WS_GLA_RP = 166 * MiB;
constexpr size_t WS_GLA_DEC = 170 * MiB;
constexpr size_t WS_S5_MAT = 171 * MiB;
constexpr size_t WS_S5_SP = 187 * MiB;
constexpr size_t WS_S5_APOW = 191 * MiB;
constexpr size_t WS_DN_WF = 192 * MiB;
constexpr size_t WS_DN_KGF = 200 * MiB;
constexpr size_t WS_DN_UF = 208 * MiB;
constexpr size_t WS_DN_QN = 216 * MiB;
constexpr size_t WS_DN_KN = 224 * MiB;
constexpr size_t WS_DN_SPF = 232 * MiB;
constexpr size_t WS_DN_VNF = 240 * MiB;
constexpr size_t WS_DN_G = 3 * MiB + 640 * 1024;
constexpr size_t WS_DN_GL = 3 * MiB + 900 * 1024;
constexpr size_t WS_END = 248 * MiB;
constexpr int COEF_STRIDE = 2048 + 32768;
constexpr int CW_BAR = 4096;
constexpr int RING_BYTES = 131072, LDSCTL_OFF = 155648  , MISC_OFF = LDSCTL_OFF + 320, ARGS_OFF = LDSCTL_OFF + 512, LDS_BYTES = 163840;

#define GAS __attribute__((address_space(1)))
#define LAS __attribute__((address_space(3)))
typedef unsigned short bf16;
typedef unsigned v4u __attribute__((ext_vector_type(4)));
typedef float f32x4 __attribute__((ext_vector_type(4)));
typedef float f32x2v __attribute__((ext_vector_type(2)));
typedef GAS unsigned gu32;
#define RLX_AGENT __ATOMIC_RELAXED, __HIP_MEMORY_SCOPE_AGENT
#define LDS_WAIT() asm volatile("s_waitcnt lgkmcnt(0)" ::: "memory")
#define VM_WAIT() asm volatile("s_waitcnt vmcnt(0)" ::: "memory")
__device__ __forceinline__ unsigned f2bf(float f) { unsigned u = __builtin_bit_cast(unsigned, f); return (u + 0x7fffu + ((u >> 16) & 1u)) >> 16; }
__device__ __forceinline__ unsigned pk2(float lo, float hi) { return f2bf(lo) | (f2bf(hi) << 16); }
__device__ __forceinline__ float bf2f(bf16 v) { return __builtin_bit_cast(float, (unsigned)v << 16); }
template <int MASK> __device__ __forceinline__ float swz_xor(float v) {
    return __builtin_bit_cast(float, __builtin_amdgcn_ds_swizzle(__builtin_bit_cast(int, v), (MASK << 10) | 0x1F));
}
__device__ __forceinline__ float xor32_add(float v) {
    unsigned a = __builtin_bit_cast(unsigned, v), b = a;
    asm volatile("s_nop 1\n\tv_permlane32_swap_b32 %0, %1" : "+v"(a), "+v"(b));
    return __builtin_bit_cast(float, a) + __builtin_bit_cast(float, b);
}
__device__ __forceinline__ float low_half_bcast(float v) {
    unsigned a = __builtin_bit_cast(unsigned, v), b = a;
    asm volatile("s_nop 1\n\tv_permlane32_swap_b32 %0, %1" : "+v"(a), "+v"(b));
    return __builtin_bit_cast(float, a);
}
__device__ __forceinline__ float wave_sum(float v) {
    v += swz_xor<1>(v); v += swz_xor<2>(v); v += swz_xor<4>(v); v += swz_xor<8>(v); v += swz_xor<16>(v);
    return xor32_add(v);
}
__device__ __forceinline__ float sigmoidf_(float x) { return 1.f / (1.f + expf(-x)); }
__device__ __forceinline__ float siluf_(float x) { return x * sigmoidf_(x); }
__device__ __forceinline__ float softplusf_(float x) { return fmaxf(x, 0.f) + log1pf(expf(-fabsf(x))); }
__device__ __forceinline__ float geluf_(float x) { return 0.5f * x * (1.f + tanhf(0.7978845608028654f * (x + 0.044715f * x * x * x))); }

#define XB_TMO      128
#define XB_XCNT(j)  (256  + 64 * (j))
#define XB_XSUB(j)  (1280 + 64 * (j))
#define XB_XGEN(j)  (2304 + 64 * (j))
#define XB_TOP      3328
#define XB_TOPGEN   3392
#define XCD_BAR_WORDS 3456
#define XB_SPIN_CAP (1u << 18)

__device__ __forceinline__ unsigned xb_ld(unsigned* p)              { return __hip_atomic_load(p, __ATOMIC_RELAXED, __HIP_MEMORY_SCOPE_AGENT); }
__device__ __forceinline__ unsigned xb_add(unsigned* p, unsigned v) { return __hip_atomic_fetch_add(p, v, __ATOMIC_RELAXED, __HIP_MEMORY_SCOPE_AGENT); }
__device__ __forceinline__ unsigned xb_xcc_id() { return (unsigned)__builtin_amdgcn_s_getreg((3 << 11) | 20) & 0xFu; }
#define XB_SPIN(cond, bar) do { unsigned _sp = 0; while (cond) { __builtin_amdgcn_s_sleep(1); \
    if ((++_sp & 255u) == 0u) { if (xb_ld(&(bar)[XB_TMO])) break; if (_sp > XB_SPIN_CAP) { atomicAdd(&(bar)[XB_TMO], 1u); break; } } } } while (0)

struct XcdBarrier {
    unsigned* bar; unsigned x;
    volatile LAS unsigned* st;
};

__device__ __forceinline__ XcdBarrier xcd_barrier_post(unsigned* bar, volatile LAS unsigned* st) {
    XcdBarrier b; b.bar = bar; b.x = xb_xcc_id(); b.st = st;
    if (threadIdx.x == 0) (void)xb_add(&bar[XB_XCNT(b.x)], 1u);
    return b;
}
__device__ __forceinline__ void xcd_barrier_complete(unsigned* bar, unsigned x, unsigned& nloc, unsigned& nx) {
    const unsigned G = gridDim.x * gridDim.y * gridDim.z;
    unsigned sum, cnt, mine, sp = 0u;
    for (;;) {
        sum = 0u; cnt = 0u; mine = 0u;
#pragma unroll
        for (unsigned j = 0; j < 16; ++j) { const unsigned c = xb_ld(&bar[XB_XCNT(j)]); sum += c; cnt += (c > 0u) ? 1u : 0u; mine = (j == x) ? c : mine; }
        if (sum == G) break;
        __builtin_amdgcn_s_sleep(1);
        if ((++sp & 255u) == 0u) { if (xb_ld(&bar[XB_TMO])) break; if (sp > XB_SPIN_CAP) { atomicAdd(&bar[XB_TMO], 1u); break; } }
    }
    nloc = mine > 0u ? mine : 1u; nx = cnt > 0u ? cnt : 1u;
}

__device__ __forceinline__ void xcd_barrier(const XcdBarrier& b) {
    asm volatile("s_waitcnt vmcnt(0)" ::: "memory");
    __syncthreads();
    if (threadIdx.x == 0) {
        unsigned* bar = b.bar; unsigned bx_ = b.x; volatile LAS unsigned* st_ = b.st; asm volatile("" : "+s"(bx_)); asm volatile("" : "+s"(bar)); asm volatile("" : "+s"(st_));
        __builtin_amdgcn_s_waitcnt(0);
        unsigned nloc = st_[0], nx = st_[1];
        if (nloc == 0u) { xcd_barrier_complete(bar, bx_, nloc, nx); st_[0] = nloc; st_[1] = nx; }
        const unsigned old = xb_add(&bar[XB_XSUB(bx_)], 1u);
        const unsigned gen = old / nloc;
        if (old + 1u == (gen + 1u) * nloc) {
            __builtin_amdgcn_fence(__ATOMIC_RELEASE, "agent");
            asm volatile("s_waitcnt vmcnt(0)" ::: "memory");
            const unsigned og = xb_add(&bar[XB_TOP], 1u);
            const unsigned tg = og / nx;
            if (og + 1u == (tg + 1u) * nx) xb_add(&bar[XB_TOPGEN], 1u);
            else XB_SPIN(xb_ld(&bar[XB_TOPGEN]) == tg, bar);
            __builtin_amdgcn_fence(__ATOMIC_ACQUIRE, "agent");
            xb_add(&bar[XB_XGEN(bx_)], 1u);
            asm volatile("s_waitcnt vmcnt(0)" ::: "memory");
        } else {
            XB_SPIN(xb_ld(&bar[XB_XGEN(bx_)]) == gen, bar);
            __builtin_amdgcn_fence(__ATOMIC_ACQUIRE, "agent");
            asm volatile("s_waitcnt vmcnt(0)" ::: "memory");
        }
    }
    __syncthreads();
}

namespace mx {
typedef short bf16x8 __attribute__((ext_vector_type(8)));
typedef short s16x4 __attribute__((ext_vector_type(4)));
typedef float f32x16 __attribute__((ext_vector_type(16)));
constexpr int IROW = 144, IMG_BYTES = 64 * IROW, WLDS = 2 * IMG_BYTES + 1024;
__device__ __forceinline__ int crow(int reg, int h) { return (reg & 3) + 8 * (reg >> 2) + 4 * h; }
__device__ __forceinline__ bf16x8 frag_row(const LAS unsigned char* img, int r0, int c0, int lane) {
    return *(const LAS bf16x8*)(img + (r0 + (lane & 31)) * IROW + (c0 + 8 * (lane >> 5)) * 2);
}
__device__ __forceinline__ bf16x8 frag_tr(const LAS unsigned char* img, int r0, int c0, int lane) {
    const int g = lane >> 4, i = lane & 15, q = i >> 2, p = i & 3;
    LAS unsigned char* a = (LAS unsigned char*)img + (r0 + 8 * (g >> 1) + q) * IROW + (c0 + 16 * (g & 1) + 4 * p) * 2;
    const s16x4 lo = __builtin_amdgcn_ds_read_tr16_b64_v4i16((LAS s16x4*)a);
    const s16x4 hi = __builtin_amdgcn_ds_read_tr16_b64_v4i16((LAS s16x4*)(a + 4 * IROW));
    return (bf16x8){lo[0], lo[1], lo[2], lo[3], hi[0], hi[1], hi[2], hi[3]};
}
__device__ __forceinline__ bf16x8 frag_row_perm(const LAS unsigned char* img, int r0, int c0, int lane) {
    const LAS unsigned char* a = img + (r0 + (lane & 31)) * IROW + (c0 + 4 * (lane >> 5)) * 2;
    const s16x4 lo = *(const LAS s16x4*)a, hi = *(const LAS s16x4*)(a + 16);
    return (bf16x8){lo[0], lo[1], lo[2], lo[3], hi[0], hi[1], hi[2], hi[3]};
}
__device__ __forceinline__ f32x16 mfma(bf16x8 a, bf16x8 b, f32x16 c) { return __builtin_amdgcn_mfma_f32_32x32x16_bf16(a, b, c, 0, 0, 0); }
__device__ __forceinline__ f32x16 zero16() { f32x16 z; for (int i = 0; i < 16; ++i) z[i] = 0.f; return z; }
__device__ __forceinline__ void unpack8(v4u w, float (&f)[8]) {
    f[0] = __builtin_bit_cast(float, w.x << 16); f[1] = __builtin_bit_cast(float, w.x & 0xffff0000u); f[2] = __builtin_bit_cast(float, w.y << 16); f[3] = __builtin_bit_cast(float, w.y & 0xffff0000u);
    f[4] = __builtin_bit_cast(float, w.z << 16); f[5] = __builtin_bit_cast(float, w.z & 0xffff0000u); f[6] = __builtin_bit_cast(float, w.w << 16); f[7] = __builtin_bit_cast(float, w.w & 0xffff0000u);
}
__device__ __forceinline__ v4u pack8(const float (&f)[8]) { v4u w; w.x = pk2(f[0], f[1]); w.y = pk2(f[2], f[3]); w.z = pk2(f[4], f[5]); w.w = pk2(f[6], f[7]); return w; }
template <int NCOL> __device__ __forceinline__ void img_load(LAS unsigned char* img, const bf16* g, int ld, int lane) {
    constexpr int CPR = NCOL / 8;
#pragma unroll
    for (int it = 0; it < CPR; ++it) { int c_ = lane + 64 * it; asm volatile("" : "+v"(c_)); const int c = c_, row = c / CPR, cc = c % CPR;
        *(LAS v4u*)(img + row * IROW + cc * 16) = *(const GAS v4u*)(g + (size_t)row * ld + cc * 8); }
}
template <int DK, class RS> __device__ __forceinline__ void la_kv(const LAS unsigned char* imgK, const LAS unsigned char* imgV, float* KV, const RS& rs, int lane) {
#pragma unroll
    for (int md = 0; md < DK / 32; ++md)
#pragma unroll
        for (int et = 0; et < 2; ++et) {
            f32x16 acc = zero16();
#pragma unroll
            for (int s = 0; s < 4; ++s) acc = mfma(frag_tr(imgK, 16 * s, 32 * md, lane), frag_tr(imgV, 16 * s, 32 * et, lane), acc);
#pragma unroll
            for (int u = 0; u < 2; ++u) { f32x4 o0, o1;
#pragma unroll
                for (int j = 0; j < 4; ++j) { o0[j] = acc[8 * u + j] * rs(32 * md + crow(8 * u + j, lane >> 5)); o1[j] = acc[8 * u + 4 + j] * rs(32 * md + crow(8 * u + 4 + j, lane >> 5)); }
                GAS f32x4* dst = (GAS f32x4*)(KV + ((size_t)((md * 2 + et) * 2 + u) * 64 + lane) * 8); dst[0] = o0; dst[1] = o1; }
        }
}
__device__ __forceinline__ void head_epilogue(const f32x16 (&o)[2][2], const bf16* Gp, int ldp, const float* norm_g, bf16* Yp, int ldy, int lane) {
#pragma unroll
    for (int it = 0; it < 2; ++it) {
        float ss = 0.f;
#pragma unroll
        for (int et = 0; et < 2; ++et)
#pragma unroll
            for (int r = 0; r < 16; ++r) ss += o[et][it][r] * o[et][it][r];
        ss = xor32_add(ss);
        const float rstd = rsqrtf(ss * (1.f / 64.f) + EPS);
        const int i = 32 * it + (lane & 31);
#pragma unroll
        for (int et = 0; et < 2; ++et)
#pragma unroll
            for (int g4 = 0; g4 < 4; ++g4) { const int e0 = 32 * et + 8 * g4 + 4 * (lane >> 5); int i_ = i; asm volatile("" : "+v"(i_));
                const unsigned long long gw = *(const GAS unsigned long long*)(Gp + (size_t)i_ * ldp + e0);
                const f32x4 gn = *(const GAS f32x4*)(norm_g + e0);
                float gt[4] = {__builtin_bit_cast(float, (unsigned)gw << 16), __builtin_bit_cast(float, (unsigned)gw & 0xffff0000u),
                               __builtin_bit_cast(float, (unsigned)(gw >> 32) << 16), __builtin_bit_cast(float, (unsigned)(gw >> 32) & 0xffff0000u)};
                float ov[4];
#pragma unroll
                for (int j = 0; j < 4; ++j) ov[j] = o[et][it][4 * g4 + j] * rstd * gn[j] * (gt[j] / (1.f + __expf(-gt[j])));
                *(GAS unsigned long long*)(Yp + (size_t)i_ * ldy + e0) = (unsigned long long)pk2(ov[0], ov[1]) | ((unsigned long long)pk2(ov[2], ov[3]) << 32); }
    }
}
template <int DK> __device__ __forceinline__ void la_out(LAS unsigned char* wl, const bf16* Qp, const bf16* Kp, int ldq, const bf16* Vp, const bf16* Gp, int ldp,
                                                         const bf16* RP, const float* norm_g, bf16* Yp, int ldy, int lane) {
    LAS unsigned char* img0 = wl; LAS unsigned char* img1 = wl + IMG_BYTES;
    img_load<DK>(img0, Qp, ldq, lane); img_load<DK>(img1, Kp, ldq, lane);
    f32x16 sc[3];
#pragma unroll
    for (int t = 0; t < 3; ++t) { const int mt = (t == 1) ? 0 : 1, nt = (t == 0) ? 0 : (t == 1 ? 0 : 1); sc[t] = zero16();
#pragma unroll
        for (int s = 0; s < DK / 16; ++s) sc[t] = mfma(frag_row(img0, 32 * mt, 16 * s, lane), frag_row(img1, 32 * nt, 16 * s, lane), sc[t]); }
    f32x16 o[2][2];
#pragma unroll
    for (int et = 0; et < 2; ++et)
#pragma unroll
        for (int it = 0; it < 2; ++it) { o[et][it] = zero16();
#pragma unroll
            for (int md = 0; md < DK / 32; ++md)
#pragma unroll
                for (int u = 0; u < 2; ++u) { const bf16x8 a = *(const GAS bf16x8*)(RP + ((size_t)((md * 2 + et) * 2 + u) * 64 + lane) * 8);
                    o[et][it] = mfma(a, frag_row_perm(img0, 32 * it, 32 * md + 16 * u, lane), o[et][it]); } }
#pragma unroll
    for (int t = 0; t < 3; ++t) { const int mt = (t == 1) ? 0 : 1, nt = (t == 0) ? 0 : (t == 1 ? 0 : 1);
#pragma unroll
        for (int r = 0; r < 16; ++r) { const int i = 32 * mt + crow(r, lane >> 5), j = 32 * nt + (lane & 31);
            *(LAS bf16*)(img0 + i * IROW + j * 2) = (bf16)f2bf(j <= i ? sc[t][r] : 0.f); } }
#pragma unroll
    for (int r = 0; r < 16; ++r) { const int i = crow(r, lane >> 5), j = 32 + (lane & 31); *(LAS bf16*)(img0 + i * IROW + j * 2) = 0; }
    img_load<64>(img1, Vp, ldp, lane);
#pragma unroll
    for (int et = 0; et < 2; ++et)
#pragma unroll
        for (int it = 0; it < 2; ++it)
#pragma unroll
            for (int s = 0; s < 4; ++s) { if (it == 0 && s >= 2) continue;
                o[et][it] = mfma(frag_tr(img1, 16 * s, 32 * et, lane), frag_row(img0, 32 * it, 16 * s, lane), o[et][it]); }
    head_epilogue(o, Gp, ldp, norm_g, Yp, ldy, lane);
}
}

__device__ __forceinline__ void ret_A(LAS unsigned char* wl, bf16* Pt  , const f32x2v* tab, int pos0, int h, float* KV, int lane) {
    LAS unsigned char* img0 = wl; LAS unsigned char* img1 = wl + mx::IMG_BYTES;
    const float lg = log2f(1.f - exp2f(-5.f - (float)h));
    const int cc = lane & 7;
#pragma unroll
    for (int it = 0; it < 8; ++it) { int row_ = (lane >> 3) + 8 * it; asm volatile("" : "+v"(row_)); const int row = row_;
        bf16* qp = Pt + (size_t)row * NP + C_RQ + h * 64 + cc * 8; bf16* kp = Pt + (size_t)row * NP + C_RK + h * 64 + cc * 8;
        float q[8], k[8]; mx::unpack8(*(const GAS v4u*)qp, q); mx::unpack8(*(const GAS v4u*)kp, k);
        const GAS f32x4* tp = (const GAS f32x4*)(tab + (size_t)(pos0 + row) * 32 + cc * 4); const f32x4 t0 = tp[0], t1 = tp[1];
        const float cs[4] = {t0[0], t0[2], t1[0], t1[2]}, sn[4] = {t0[1], t0[3], t1[1], t1[3]};
        const float dq = 0.125f * exp2f((float)(row + 1) * lg), dk = exp2f(-(float)(row + 1) * lg);
        float qo[8], ko[8];
#pragma unroll
        for (int pz = 0; pz < 4; ++pz) { qo[2 * pz] = (q[2 * pz] * cs[pz] - q[2 * pz + 1] * sn[pz]) * dq; qo[2 * pz + 1] = (q[2 * pz] * sn[pz] + q[2 * pz + 1] * cs[pz]) * dq;
            ko[2 * pz] = (k[2 * pz] * cs[pz] - k[2 * pz + 1] * sn[pz]) * dk; ko[2 * pz + 1] = (k[2 * pz] * sn[pz] + k[2 * pz + 1] * cs[pz]) * dk; }
        const v4u kw = mx::pack8(ko);
        *(GAS v4u*)qp = mx::pack8(qo); *(GAS v4u*)kp = kw;
        *(LAS v4u*)(img0 + row * mx::IROW + cc * 16) = kw; }
    mx::img_load<64>(img1, Pt + C_RV + h * 64, NP, lane);
    const float g64 = exp2f(64.f * lg);
    mx::la_kv<64>(img0, img1, KV, [g64](int) { return g64; }, lane);
}
__device__ __forceinline__ void gla_A(LAS unsigned char* wl, bf16* Pt, const float* w_gk  , const float* b_gk, int h, float* KV, float* DEC, int lane) {
    LAS unsigned char* img0 = wl; LAS unsigned char* img1 = wl + mx::IMG_BYTES; LAS float* vec = (LAS float*)(wl + 2 * mx::IMG_BYTES);
    LAS float* cumL = (LAS float*)img1;
    const int hh = lane >> 5, d = lane & 31;
    float wg[16];
#pragma unroll
    for (int r = 0; r < 16; ++r) wg[r] = w_gk[r * 128 + h * 32 + d];
    const float bg = b_gk[h * 32 + d];
    float cum = 0.f;
    { const bf16* pr = Pt + (size_t)(32 * hh) * NP + C_GCODE;
#pragma unroll 4
      for (int jj = 0; jj < 32; ++jj, pr += NP) {
        float a[8], b[8]; mx::unpack8(*(const GAS v4u*)pr, a); mx::unpack8(*(const GAS v4u*)(pr + 8), b);
        float z = bg;
#pragma unroll
        for (int r = 0; r < 8; ++r) z += a[r] * wg[r] + b[r] * wg[8 + r];
        cum += -softplusf_(-z) * (1.f / 16.f); cumL[(32 * hh + jj) * 32 + d] = cum; } }
    const float first_tot = low_half_bcast(cum);
    const float add = hh ? first_tot : 0.f;
    if (hh) vec[d] = expf(cum + first_tot);
    const float qs = 0.17677669529663687f;
    { GAS bf16* qp = (GAS bf16*)(Pt + (size_t)(32 * hh) * NP + C_GQ + h * 32 + d); GAS bf16* kp = (GAS bf16*)(Pt + (size_t)(32 * hh) * NP + C_GK + h * 32 + d);
#pragma unroll 4
      for (int jj = 0; jj < 32; ++jj, qp += NP, kp += NP) { const int row = 32 * hh + jj;
        const float e = expf(cumL[row * 32 + d] + add);
        const bf16 qv = (bf16)f2bf(bf2f(*qp) * qs * e), kv = (bf16)f2bf(bf2f(*kp) / e);
        *qp = qv; *kp = kv; *(LAS bf16*)(img0 + row * mx::IROW + d * 2) = kv; } }
    LDS_WAIT();
    mx::img_load<64>(img1, Pt + C_GV + h * 64, NP, lane);
    if (lane < 32) DEC[lane] = vec[lane];
    mx::la_kv<32>(img0, img1, KV, [vec](int dd) { return vec[dd]; }, lane);
}
template <int NMD> __device__ __forceinline__ void la_scan(const float* KV, bf16* RP, const float* DEC, float g64, int sub  , int lane) {
    constexpr int CH = NMD * 4 * 64 * 8;
    const int u = sub & 1, h = lane >> 5;
    float st[8];
#pragma unroll
    for (int j = 0; j < 8; ++j) st[j] = 0.f;
    const float* kp = KV + ((size_t)sub * 64 + lane) * 8; bf16* rp = RP + ((size_t)sub * 64 + lane) * 8;
    for (int n0 = 0; n0 < 128; n0 += 8) {
        f32x4 a[8][2], dc[8][2];
#pragma unroll
        for (int n = 0; n < 8; ++n) { const GAS f32x4* src = (const GAS f32x4*)(kp + (size_t)(n0 + n) * CH); a[n][0] = src[0]; a[n][1] = src[1];
            if (DEC) { const float* dp = DEC + (size_t)(n0 + n) * 32 + 16 * u + 4 * h; dc[n][0] = *(const GAS f32x4*)dp; dc[n][1] = *(const GAS f32x4*)(dp + 8); }
            else { dc[n][0] = (f32x4){g64, g64, g64, g64}; dc[n][1] = dc[n][0]; } }
#pragma unroll
        for (int n = 0; n < 8; ++n) {
            *(GAS v4u*)(rp + (size_t)(n0 + n) * CH) = mx::pack8(st);
#pragma unroll
            for (int j = 0; j < 4; ++j) { st[j] = st[j] * dc[n][0][j] + a[n][0][j]; st[4 + j] = st[4 + j] * dc[n][1][j] + a[n][1][j]; }
        }
    }
}

constexpr size_t S5_MAT_LAYER = 4 * MiB, S5_EM_OFF = 0, S5_KM_OFF = 1 * MiB, S5_CM_OFF = 3 * MiB;
template <bool OUT> __device__ __forceinline__ void s5_item(bf16* Pm  , const unsigned char* mats  , float* E, const bf16* SP, int g, int mu, int lane) {
    using namespace mx;
    const int m = lane & 31, hf = lane >> 5;
    bf16x8 A[16];
    { const bf16* ap = Pm + (size_t)((mu * 32 + m) * 16) * NP + g * 16 + 8 * hf;
#pragma unroll
      for (int j = 0; j < 16; ++j) A[j] = *(const GAS bf16x8*)(ap + (size_t)j * NP); }
    if constexpr (!OUT) {
        const bf16* em = (const bf16*)(mats + S5_EM_OFF) + (size_t)g * 128 * 256;
#pragma unroll 1
        for (int nt = 0; nt < 4; ++nt) {
            f32x16 acc = zero16();
            const bf16* bp = em + (size_t)(32 * nt + m) * 256 + 8 * hf;
#pragma unroll
            for (int s = 0; s < 16; ++s) acc = mfma(A[s], *(const GAS bf16x8*)(bp + 16 * s), acc);
            float* ep = E + (size_t)(mu * 32) * 2048 + g * 128 + 32 * nt + m;
#pragma unroll
            for (int r = 0; r < 16; ++r) ((GAS float*)ep)[(size_t)crow(r, hf) * 2048] = acc[r];
        }
    } else {
        bf16x8 A2[8];
        { const bf16* sp = SP + (size_t)(mu * 32 + m) * 2048 + g * 128 + 8 * hf;
#pragma unroll
          for (int s = 0; s < 8; ++s) A2[s] = *(const GAS bf16x8*)(sp + 16 * s); }
        const bf16* km = (const bf16*)(mats + S5_KM_OFF) + (size_t)g * 256 * 256;
        const bf16* cm = (const bf16*)(mats + S5_CM_OFF) + (size_t)g * 256 * 128;
#pragma unroll 1
        for (int nt = 0; nt < 8; ++nt) {
            f32x16 acc = zero16();
            const bf16* bp = km + (size_t)(32 * nt + m) * 256 + 8 * hf;
            const bf16* cp = cm + (size_t)(32 * nt + m) * 128 + 8 * hf;
#pragma unroll
            for (int s = 0; s < 16; ++s) acc = mfma(A[s], *(const GAS bf16x8*)(bp + 16 * s), acc);
#pragma unroll
            for (int s = 0; s < 8; ++s) acc = mfma(A2[s], *(const GAS bf16x8*)(cp + 16 * s), acc);
            bf16* yp = Pm + (size_t)((mu * 32) * 16 + 2 * nt + (m >> 4)) * NP + g * 16 + (m & 15);
#pragma unroll
            for (int r = 0; r < 16; ++r) ((GAS bf16*)yp)[(size_t)(crow(r, hf) * 16) * NP] = (bf16)f2bf(geluf_(acc[r]));
        }
    }
}
__device__ __forceinline__ void s5_scan_block(LAS float* sh  , const float* E  , bf16* SP, const float* a16p  , int g, int tid) {
    const int p = tid & 63, seg = tid >> 6;
    const float ar = a16p[2 * p], ai = a16p[2 * p + 1];
    const float* er = E + (size_t)(seg * 64) * 2048 + g * 128 + p;
    float sr = 0.f, si = 0.f;
    for (int n0 = 0; n0 < 64; n0 += 8) { float xr[8], xi[8];
#pragma unroll
        for (int n = 0; n < 8; ++n) { xr[n] = ((const GAS float*)er)[(size_t)(n0 + n) * 2048]; xi[n] = ((const GAS float*)er)[(size_t)(n0 + n) * 2048 + 64]; }
#pragma unroll
        for (int n = 0; n < 8; ++n) { const float nr = ar * sr - ai * si + xr[n], ni = ar * si + ai * sr + xi[n]; sr = nr; si = ni; } }
    sh[(seg * 64 + p) * 2] = sr; sh[(seg * 64 + p) * 2 + 1] = si;
    float br = ar, bi = ai;
#pragma unroll
    for (int k = 0; k < 6; ++k) { const float nr = br * br - bi * bi, ni = 2.f * br * bi; br = nr; bi = ni; }
    __syncthreads();
    sr = 0.f; si = 0.f;
    for (int s2 = 0; s2 < seg; ++s2) { const float lr = sh[(s2 * 64 + p) * 2], li = sh[(s2 * 64 + p) * 2 + 1]; const float nr = br * sr - bi * si + lr, ni = br * si + bi * sr + li; sr = nr; si = ni; }
    bf16* sp = SP + (size_t)(seg * 64) * 2048 + g * 128 + p;
    for (int n0 = 0; n0 < 64; n0 += 8) { float xr[8], xi[8];
#pragma unroll
        for (int n = 0; n < 8; ++n) { xr[n] = ((const GAS float*)er)[(size_t)(n0 + n) * 2048]; xi[n] = ((const GAS float*)er)[(size_t)(n0 + n) * 2048 + 64]; }
#pragma unroll
        for (int n = 0; n < 8; ++n) { ((GAS bf16*)sp)[(size_t)(n0 + n) * 2048] = (bf16)f2bf(sr); ((GAS bf16*)sp)[(size_t)(n0 + n) * 2048 + 64] = (bf16)f2bf(si);
            const float nr = ar * sr - ai * si + xr[n], ni = ar * si + ai * sr + xi[n]; sr = nr; si = ni; } }
    __syncthreads();
}

typedef float f32x4m __attribute__((ext_vector_type(4)));
__device__ __forceinline__ f32x4m mfma16(mx::bf16x8 a, mx::bf16x8 b, f32x4m c) { return __builtin_amdgcn_mfma_f32_16x16x32_bf16(a, b, c, 0, 0, 0); }
__device__ __forceinline__ mx::bf16x8 pack_bf8(f32x4m a, f32x4m b) {
    const unsigned w0 = pk2(a[0], a[1]), w1 = pk2(a[2], a[3]), w2 = pk2(b[0], b[1]), w3 = pk2(b[2], b[3]);
    const v4u w = {w0, w1, w2, w3}; return __builtin_bit_cast(mx::bf16x8, w);
}
template <int I, int C8> __device__ __forceinline__ void fs_chunk(const float (&t)[64], const LAS unsigned char* img1, float& a0, float& a1) {
    if constexpr (C8 * 8 < I) {
        float a[8]; mx::unpack8(*(const LAS v4u*)(img1 + I * mx::IROW + C8 * 16), a);
        if constexpr (C8 * 8 + 0 < I) a0 -= a[0] * t[C8 * 8 + 0];
        if constexpr (C8 * 8 + 1 < I) a1 -= a[1] * t[C8 * 8 + 1];
        if constexpr (C8 * 8 + 2 < I) a0 -= a[2] * t[C8 * 8 + 2];
        if constexpr (C8 * 8 + 3 < I) a1 -= a[3] * t[C8 * 8 + 3];
        if constexpr (C8 * 8 + 4 < I) a0 -= a[4] * t[C8 * 8 + 4];
        if constexpr (C8 * 8 + 5 < I) a1 -= a[5] * t[C8 * 8 + 5];
        if constexpr (C8 * 8 + 6 < I) a0 -= a[6] * t[C8 * 8 + 6];
        if constexpr (C8 * 8 + 7 < I) a1 -= a[7] * t[C8 * 8 + 7];
        fs_chunk<I, C8 + 1>(t, img1, a0, a1);
    }
}
template <int I> __device__ __forceinline__ void fs_row(float (&t)[64], const LAS unsigned char* img1, int lane) {
    if constexpr (I < 64) {
        float a0 = -bf2f(*(const LAS bf16*)(img1 + I * mx::IROW + lane * 2)), a1 = 0.f;
        fs_chunk<I, 0>(t, img1, a0, a1);
        t[I] = a0 + a1;
        fs_row<I + 1>(t, img1, lane);
    }
}
template <int I> __device__ __forceinline__ void fs_store(const float (&t)[64], LAS unsigned char* img1, int lane) {
    if constexpr (I < 64) { *(LAS bf16*)(img1 + I * mx::IROW + lane * 2) = (bf16)f2bf(t[I]); fs_store<I + 1>(t, img1, lane); }
}
template <class F> __device__ __forceinline__ void dn_conv_rows(const bf16* Pt, int col0, const float* cw, int wcol0, int n, int lane, F&& f) {
    const int cc = lane & 7;
    f32x4 w[4][2];
#pragma unroll
    for (int j = 0; j < 4; ++j) { w[j][0] = *(const GAS f32x4*)(cw + j * 768 + wcol0 + cc * 8); w[j][1] = *(const GAS f32x4*)(cw + j * 768 + wcol0 + cc * 8 + 4); }
#pragma unroll
    for (int it = 0; it < 8; ++it) { int row_ = (lane >> 3) + 8 * it; asm volatile("" : "+v"(row_)); const int row = row_;
        float x[8];
#pragma unroll
        for (int e = 0; e < 8; ++e) x[e] = 0.f;
#pragma unroll
        for (int j = 0; j < 4; ++j) { const int rr = row - 3 + j;
            if (n > 0 || rr >= 0) { float r[8]; mx::unpack8(*(const GAS v4u*)(Pt + (ptrdiff_t)rr * NP + col0 + cc * 8), r);
#pragma unroll
                for (int e = 0; e < 4; ++e) { x[e] += w[j][0][e] * r[e]; x[4 + e] += w[j][1][e] * r[4 + e]; } } }
#pragma unroll
        for (int e = 0; e < 8; ++e) x[e] = x[e] / (1.f + __expf(-x[e]));
        f(it, row, cc, x); }
}
struct DnBufs { bf16* WF; bf16* KGF; bf16* UF; bf16* QN; bf16* KN; float* G; float* GL; };
__device__ __forceinline__ void dn_A(LAS unsigned char* wl, const bf16* Pt, size_t t0g, int n, int h, int item, const float* cw, float a_log, float dt_bias, const DnBufs& B, int lane_in) {
    using namespace mx;
    int lane_l = lane_in; asm volatile("" : "+v"(lane_l)); const int lane = lane_l;
    LAS unsigned char* img0 = wl; LAS unsigned char* img1 = wl + IMG_BYTES; LAS float* vec = (LAS float*)(wl + 2 * IMG_BYTES);
    LAS float* vb = vec; LAS float* vg = vec + 64; LAS float* ve = vec + 128; LAS float* vs = vec + 192;
    const int hf = lane >> 5;
    {
        const float bin = bf2f(*(const GAS bf16*)(Pt + (size_t)lane * NP + C_DBETA + h)), ain = bf2f(*(const GAS bf16*)(Pt + (size_t)lane * NP + C_DA + h));
        const float beta = 1.f / (1.f + expf(-bin)), gj = -expf(a_log) * softplusf_(ain + dt_bias);
        float gc = gj;
#pragma unroll
        for (int sft = 1; sft < 64; sft <<= 1) { ve[lane] = gc; LDS_WAIT(); const float o = ve[lane >= sft ? lane - sft : 0]; LDS_WAIT(); gc += (lane >= sft) ? o : 0.f; }
        vg[lane] = gc; vb[lane] = beta;
        LDS_WAIT();
        const float glast = vg[63];
        ve[lane] = expf(glast - gc); vs[lane] = beta * expf(gc);
        ((GAS float*)B.G)[(t0g + lane) * 4 + h] = gc;
        if (lane == 0) ((GAS float*)B.GL)[item] = expf(glast);
        LDS_WAIT();
    }
    dn_conv_rows(Pt, C_DQKV + 256 + h * 64, cw, 256 + h * 64, n, lane, [&](int, int row, int cc, float (&x)[8]) {
        float ss = 0.f;
#pragma unroll
        for (int e = 0; e < 8; ++e) ss += x[e] * x[e];
        ss += swz_xor<1>(ss); ss += swz_xor<2>(ss); ss += swz_xor<4>(ss);
        const float rs = rsqrtf(ss + EPS);
#pragma unroll
        for (int e = 0; e < 8; ++e) x[e] *= rs;
        const v4u w = pack8(x);
        *(LAS v4u*)(img0 + row * IROW + cc * 16) = w; *(GAS v4u*)(B.KN + (t0g + row) * 256 + h * 64 + cc * 8) = w; });
    dn_conv_rows(Pt, C_DQKV + h * 64, cw, h * 64, n, lane, [&](int, int row, int cc, float (&x)[8]) {
        float ss = 0.f;
#pragma unroll
        for (int e = 0; e < 8; ++e) ss += x[e] * x[e];
        ss += swz_xor<1>(ss); ss += swz_xor<2>(ss); ss += swz_xor<4>(ss);
        const float rs = rsqrtf(ss + EPS) * 0.125f;
#pragma unroll
        for (int e = 0; e < 8; ++e) x[e] *= rs;
        *(GAS v4u*)(B.QN + (t0g + row) * 256 + h * 64 + cc * 8) = pack8(x); });
    LDS_WAIT();
#pragma unroll
    for (int t = 0; t < 3; ++t) { const int mt = (t == 1) ? 0 : 1, nt = (t == 2) ? 1 : 0;
        f32x16 acc = zero16();
#pragma unroll
        for (int s = 0; s < 4; ++s) acc = mfma(frag_row(img0, 32 * mt, 16 * s, lane), frag_row(img0, 32 * nt, 16 * s, lane), acc);
        const int j = 32 * nt + (lane & 31); const float gj = vg[j];
#pragma unroll
        for (int g4 = 0; g4 < 4; ++g4) { const int i0 = 32 * mt + 8 * g4 + 4 * hf; const f32x4 b4 = *(const LAS f32x4*)(vb + i0), g4v = *(const LAS f32x4*)(vg + i0);
#pragma unroll
            for (int e = 0; e < 4; ++e) { const int i = i0 + e; const float a = b4[e] * acc[4 * g4 + e] * __expf(fminf(g4v[e] - gj, 0.f));
                *(LAS bf16*)(img1 + i * IROW + j * 2) = (bf16)f2bf(j < i ? a : 0.f); } } }
#pragma unroll
    for (int r = 0; r < 16; ++r) { const int i = crow(r, hf), j = 32 + (lane & 31); *(LAS bf16*)(img1 + i * IROW + j * 2) = 0; }
    LDS_WAIT();
    {
        float t[64];
        fs_row<0>(t, img1, lane);
        LDS_WAIT();
        fs_store<0>(t, img1, lane);
        LDS_WAIT();
        *(LAS bf16*)(img1 + lane * mx::IROW + lane * 2) = (bf16)0x3f80;
    }
    {
        const int kg = lane >> 4, i16 = lane & 15, q = i16 >> 2, p = i16 & 3;
#pragma unroll
        for (int t = 0; t < 4; ++t)
#pragma unroll
            for (int s = 0; s < 2; ++s) { float o[8];
#pragma unroll
                for (int m = 0; m < 2; ++m) { const int c0 = 32 * s + 16 * m + 4 * kg;
                    const s16x4 x = __builtin_amdgcn_ds_read_tr16_b64_v4i16((LAS s16x4*)(img0 + (c0 + q) * IROW + (16 * t + 4 * p) * 2));
                    const f32x4 f = *(const LAS f32x4*)(ve + c0);
#pragma unroll
                    for (int e = 0; e < 4; ++e) o[4 * m + e] = bf2f((bf16)x[e]) * f[e]; }
                *(GAS v4u*)(B.KGF + ((size_t)((item * 4 + t) * 2 + s) * 64 + lane) * 8) = pack8(o); }
    }
#pragma unroll
    for (int it = 0; it < 8; ++it) { int c_ = lane + 64 * it; asm volatile("" : "+v"(c_)); const int row = c_ >> 3, cc = c_ & 7;
        float x[8]; unpack8(*(const LAS v4u*)(img0 + row * IROW + cc * 16), x); const float sc = vs[row];
#pragma unroll
        for (int e = 0; e < 8; ++e) x[e] *= sc;
        *(LAS v4u*)(img0 + row * IROW + cc * 16) = pack8(x); }
    LDS_WAIT();
    {
        f32x16 w[2][2];
#pragma unroll
        for (int mt = 0; mt < 2; ++mt)
#pragma unroll
            for (int nt = 0; nt < 2; ++nt) { w[mt][nt] = zero16();
#pragma unroll
                for (int s = 0; s < 4; ++s) { if (mt == 0 && s >= 2) continue; w[mt][nt] = mfma(frag_row(img1, 32 * mt, 16 * s, lane), frag_tr(img0, 16 * s, 32 * nt, lane), w[mt][nt]); } }
#pragma unroll
        for (int mt = 0; mt < 2; ++mt)
#pragma unroll
            for (int nt = 0; nt < 2; ++nt)
#pragma unroll
                for (int r = 0; r < 16; ++r) *(LAS bf16*)(img0 + (32 * mt + crow(r, hf)) * IROW + (32 * nt + (lane & 31)) * 2) = (bf16)f2bf(w[mt][nt][r]);
        LDS_WAIT();
        const int kg = lane >> 4;
#pragma unroll
        for (int tc = 0; tc < 4; ++tc)
#pragma unroll
            for (int s = 0; s < 2; ++s) { const LAS unsigned char* a = img0 + (16 * tc + (lane & 15)) * IROW + (32 * s + 4 * kg) * 2;
                const s16x4 lo = *(const LAS s16x4*)a, hi = *(const LAS s16x4*)(a + 32);
                const bf16x8 v = {lo[0], lo[1], lo[2], lo[3], hi[0], hi[1], hi[2], hi[3]};
                *(GAS bf16x8*)(B.WF + ((size_t)((item * 4 + tc) * 2 + s) * 64 + lane) * 8) = v; }
        LDS_WAIT();
    }
    dn_conv_rows(Pt, C_DQKV + 512 + h * 64, cw, 512 + h * 64, n, lane, [&](int, int row, int cc, float (&x)[8]) {
        const float bt = vb[row];
#pragma unroll
        for (int e = 0; e < 8; ++e) x[e] *= bt;
        *(LAS v4u*)(img0 + row * IROW + cc * 16) = pack8(x); });
    LDS_WAIT();
#pragma unroll
    for (int mt = 0; mt < 2; ++mt)
#pragma unroll
        for (int nt = 0; nt < 2; ++nt) { f32x16 u = zero16();
#pragma unroll
            for (int s = 0; s < 4; ++s) { if (mt == 0 && s >= 2) continue; u = mfma(frag_row(img1, 32 * mt, 16 * s, lane), frag_tr(img0, 16 * s, 32 * nt, lane), u); }
            const int el = lane & 31;
#pragma unroll
            for (int g4 = 0; g4 < 4; ++g4) { const int tc = 2 * mt + (g4 >> 1), q_ = 2 * (g4 & 1) + hf, slc = 2 * nt + (el >> 4), lp = (el & 15) + 16 * q_;
                *(GAS unsigned long long*)(B.UF + ((size_t)((item * 4 + slc) * 4 + tc) * 64 + lp) * 4) = (unsigned long long)pk2(u[4 * g4], u[4 * g4 + 1]) | ((unsigned long long)pk2(u[4 * g4 + 2], u[4 * g4 + 3]) << 32); } }
    LDS_WAIT();
}
__device__ __forceinline__ void dn_scan(const bf16* WF, const bf16* KGF, const bf16* UF, const float* GL, bf16* SPF, bf16* VNF, int bh, int slc, int lane) {
    using mx::bf16x8;
    f32x4m S[4];
#pragma unroll
    for (int t = 0; t < 4; ++t) S[t] = (f32x4m){0.f, 0.f, 0.f, 0.f};
    const int e16 = lane & 15, q_ = lane >> 4, lp = 16 * (slc & 1) + e16 + 32 * (q_ & 1), et = slc >> 1;
    bf16x8 W[4][2], KG[4][2]; unsigned long long U[4]; float gl;
    { const int item = bh * 128;
#pragma unroll
      for (int t = 0; t < 4; ++t) {
#pragma unroll
        for (int s = 0; s < 2; ++s) { W[t][s] = *(const GAS bf16x8*)(WF + ((size_t)((item * 4 + t) * 2 + s) * 64 + lane) * 8); KG[t][s] = *(const GAS bf16x8*)(KGF + ((size_t)((item * 4 + t) * 2 + s) * 64 + lane) * 8); }
        U[t] = *(const GAS unsigned long long*)(UF + ((size_t)((item * 4 + slc) * 4 + t) * 64 + lane) * 4); }
      gl = ((const GAS float*)GL)[item]; }
#pragma unroll 1
    for (int n = 0; n < 128; ++n) {
        const int item = bh * 128 + n, nx = bh * 128 + (n + 1 < 128 ? n + 1 : n);
        bf16x8 nW[4][2], nKG[4][2]; unsigned long long nU[4];
#pragma unroll
        for (int t = 0; t < 4; ++t) {
#pragma unroll
            for (int s = 0; s < 2; ++s) { nW[t][s] = *(const GAS bf16x8*)(WF + ((size_t)((nx * 4 + t) * 2 + s) * 64 + lane) * 8); nKG[t][s] = *(const GAS bf16x8*)(KGF + ((size_t)((nx * 4 + t) * 2 + s) * 64 + lane) * 8); }
            nU[t] = *(const GAS unsigned long long*)(UF + ((size_t)((nx * 4 + slc) * 4 + t) * 64 + lane) * 4); }
        const float ngl = ((const GAS float*)GL)[nx];
        const bf16x8 Sb0 = pack_bf8(S[0], S[1]), Sb1 = pack_bf8(S[2], S[3]);
        f32x4m vn[4];
#pragma unroll
        for (int t = 0; t < 4; ++t) { f32x4m acc = {0.f, 0.f, 0.f, 0.f}; acc = mfma16(W[t][0], Sb0, acc); acc = mfma16(W[t][1], Sb1, acc);
            const unsigned lo = (unsigned)U[t], hi = (unsigned)(U[t] >> 32);
            vn[t][0] = __builtin_bit_cast(float, lo << 16) - acc[0]; vn[t][1] = __builtin_bit_cast(float, lo & 0xffff0000u) - acc[1];
            vn[t][2] = __builtin_bit_cast(float, hi << 16) - acc[2]; vn[t][3] = __builtin_bit_cast(float, hi & 0xffff0000u) - acc[3]; }
        const bf16x8 vb0 = pack_bf8(vn[0], vn[1]), vb1 = pack_bf8(vn[2], vn[3]);
        { const size_t b0 = ((size_t)((item * 2 + et) * 4 + (q_ >> 1)) * 64 + lp) * 8, b1 = ((size_t)((item * 2 + et) * 4 + 2 + (q_ >> 1)) * 64 + lp) * 8;
          *(GAS bf16x8*)(SPF + b0) = Sb0; *(GAS bf16x8*)(SPF + b1) = Sb1; *(GAS bf16x8*)(VNF + b0) = vb0; *(GAS bf16x8*)(VNF + b1) = vb1; }
#pragma unroll
        for (int t = 0; t < 4; ++t) { f32x4m acc = S[t] * gl; acc = mfma16(KG[t][0], vb0, acc); acc = mfma16(KG[t][1], vb1, acc); S[t] = acc; }
#pragma unroll
        for (int t = 0; t < 4; ++t) { W[t][0] = nW[t][0]; W[t][1] = nW[t][1]; KG[t][0] = nKG[t][0]; KG[t][1] = nKG[t][1]; U[t] = nU[t]; }
        gl = ngl;
    }
}
__device__ __forceinline__ mx::bf16x8 fragB_perm16(const LAS unsigned char* img, int r0, int sp, int lane) {
    const int q = 2 * (sp & 1) + (lane >> 5), tp = sp >> 1;
    const LAS unsigned char* a = img + (r0 + (lane & 31)) * mx::IROW + (32 * tp + 4 * q) * 2;
    const mx::s16x4 lo = *(const LAS mx::s16x4*)a, hi = *(const LAS mx::s16x4*)(a + 32);
    return (mx::bf16x8){lo[0], lo[1], lo[2], lo[3], hi[0], hi[1], hi[2], hi[3]};
}
__device__ __forceinline__ void dn_out(LAS unsigned char* wl, const bf16* QN, const bf16* KN  , const float* G  ,
                                       const bf16* SPF, const bf16* VNF  , const bf16* Gp, int ldp, const float* norm_g, bf16* Yp, int ldy, int lane) {
    using namespace mx;
    LAS unsigned char* img0 = wl; LAS unsigned char* img1 = wl + IMG_BYTES; LAS float* vg = (LAS float*)(wl + 2 * IMG_BYTES);
    const int hf = lane >> 5;
    vg[lane] = ((const GAS float*)G)[(size_t)lane * 4];
    img_load<64>(img0, QN, 256, lane); img_load<64>(img1, KN, 256, lane);
    LDS_WAIT();
    f32x16 o[2][2];
#pragma unroll
    for (int et = 0; et < 2; ++et)
#pragma unroll
        for (int it = 0; it < 2; ++it) { o[et][it] = zero16();
#pragma unroll
            for (int sp = 0; sp < 4; ++sp) o[et][it] = mfma(*(const GAS bf16x8*)(SPF + ((size_t)(et * 4 + sp) * 64 + lane) * 8), fragB_perm16(img0, 32 * it, sp, lane), o[et][it]);
            const float eg = __expf(vg[32 * it + (lane & 31)]);
#pragma unroll
            for (int r = 0; r < 16; ++r) o[et][it][r] *= eg; }
    f32x16 sc[3];
#pragma unroll
    for (int t = 0; t < 3; ++t) { const int mt = (t == 1) ? 0 : 1, nt = (t == 2) ? 1 : 0; sc[t] = zero16();
#pragma unroll
        for (int s = 0; s < 4; ++s) sc[t] = mfma(frag_row(img0, 32 * mt, 16 * s, lane), frag_row(img1, 32 * nt, 16 * s, lane), sc[t]); }
#pragma unroll
    for (int t = 0; t < 3; ++t) { const int mt = (t == 1) ? 0 : 1, nt = (t == 2) ? 1 : 0; const int j = 32 * nt + (lane & 31); const float gj = vg[j];
#pragma unroll
        for (int g4 = 0; g4 < 4; ++g4) { const int i0 = 32 * mt + 8 * g4 + 4 * hf; const f32x4 gi = *(const LAS f32x4*)(vg + i0);
#pragma unroll
            for (int e = 0; e < 4; ++e) { const int i = i0 + e; const float a = sc[t][4 * g4 + e] * __expf(fminf(gi[e] - gj, 0.f));
                *(LAS bf16*)(img0 + i * IROW + j * 2) = (bf16)f2bf(j <= i ? a : 0.f); } } }
#pragma unroll
    for (int r = 0; r < 16; ++r) { const int i = crow(r, hf), j = 32 + (lane & 31); *(LAS bf16*)(img0 + i * IROW + j * 2) = 0; }
    LDS_WAIT();
#pragma unroll
    for (int et = 0; et < 2; ++et)
#pragma unroll
        for (int it = 0; it < 2; ++it)
#pragma unroll
            for (int sp = 0; sp < 4; ++sp) { if (it == 0 && sp >= 2) continue;
                o[et][it] = mfma(*(const GAS bf16x8*)(VNF + ((size_t)(et * 4 + sp) * 64 + lane) * 8), fragB_perm16(img0, 32 * it, sp, lane), o[et][it]); }
    mx::head_epilogue(o, Gp, ldp, norm_g, Yp, ldy, lane);
}

struct Args { const float* in[23]; float* out; unsigned char* ws; };

__device__ __forceinline__ void p0_transpose_item(const float* W, int K, int N, bf16* WT, LAS float* scr, int item, int lane) {
    const int nblk = (N + 31) / 32, kb = item / nblk, nb = item % nblk, k0 = 64 * kb, n0 = 32 * nb;
#pragma unroll 8
    for (int i = 0; i < 32; ++i) { const int kk = 2 * i + (lane >> 5), n = n0 + (lane & 31); scr[kk * 33 + (lane & 31)] = (n < N) ? W[(size_t)(k0 + kk) * N + n] : 0.f; }
    LDS_WAIT();
    const int c = lane & 7;
#pragma unroll
    for (int j = 0; j < 4; ++j) { const int n = (lane >> 3) + 8 * j; const LAS float* s = scr + (8 * c) * 33 + n;
        v4u o; o.x = pk2(s[0 * 33], s[1 * 33]); o.y = pk2(s[2 * 33], s[3 * 33]); o.z = pk2(s[4 * 33], s[5 * 33]); o.w = pk2(s[6 * 33], s[7 * 33]);
        *(GAS v4u*)(WT + (size_t)(n0 + n) * K + k0 + 8 * c) = o; }
    LDS_WAIT();
}

__device__ __forceinline__ void task_ret(LAS float* scr, const bf16* P, const f32x2v* tab, const float* norm_g, bf16* Y, int h, int lane) {
    const float gamma = 1.f - exp2f(-5.f - (float)h);
    float S[64];
#pragma unroll
    for (int d = 0; d < 64; ++d) S[d] = 0.f;
    const float gn = norm_g[lane];
    const bf16* pr = P + h * 64 + lane;
    bf16 nq = pr[C_RQ], nk = pr[C_RK], nv = pr[C_RV], ng = pr[C_RG]; f32x2v ncs = tab[lane >> 1];
    for (int t = 0; t < L; ++t) {
        const float q = bf2f(nq), k = bf2f(nk), v = bf2f(nv), gate = bf2f(ng); const float cs = ncs.x, sn = ncs.y;
        { const int tn = (t + 1 < L) ? t + 1 : t; const bf16* pn = pr + (size_t)tn * NP; nq = pn[C_RQ]; nk = pn[C_RK]; nv = pn[C_RV]; ng = pn[C_RG]; ncs = tab[tn * 32 + (lane >> 1)]; }
        const float qo = swz_xor<1>(q), ko = swz_xor<1>(k);
        const float qr = (lane & 1) ? (qo * sn + q * cs) : (q * cs - qo * sn);
        const float kr = (lane & 1) ? (ko * sn + k * cs) : (k * cs - ko * sn);
        scr[lane] = qr * 0.125f; scr[64 + lane] = kr;
        LDS_WAIT();
        float o = 0.f;
#pragma unroll
        for (int d = 0; d < 64; ++d) { S[d] = gamma * S[d] + scr[64 + d] * v; o += scr[d] * S[d]; }
        LDS_WAIT();
        const float ms = wave_sum(o * o) * (1.f / 64.f);
        Y[(size_t)t * D + 0 + h * 64 + lane] = (bf16)f2bf(o * rsqrtf(ms + EPS) * gn * siluf_(gate));
    }
}
__device__ __forceinline__ void task_dn(LAS float* scr, const bf16* P, const float* cw  , float a_log, float dt_bias, const float* norm_g, bf16* Y, int h, int lane) {
    float S[64];
#pragma unroll
    for (int d = 0; d < 64; ++d) S[d] = 0.f;
    const float gn = norm_g[lane], A = -expf(a_log);
    float wq[4], wk[4], wv[4];
#pragma unroll
    for (int j = 0; j < 4; ++j) { wq[j] = cw[j * 768 + h * 64 + lane]; wk[j] = cw[j * 768 + 256 + h * 64 + lane]; wv[j] = cw[j * 768 + 512 + h * 64 + lane]; }
    float xq0 = 0.f, xq1 = 0.f, xq2 = 0.f, xk0 = 0.f, xk1 = 0.f, xk2 = 0.f, xv0 = 0.f, xv1 = 0.f, xv2 = 0.f;
    const bf16* pr = P + h * 64 + lane;
    bf16 nq = pr[C_DQKV], nk = pr[C_DQKV + 256], nv = pr[C_DQKV + 512], ng = pr[C_DG], nb = P[C_DBETA + h], na = P[C_DA + h];
    for (int t = 0; t < L; ++t) {
        const float rq = bf2f(nq), rk = bf2f(nk), rv = bf2f(nv), gate = bf2f(ng), bin = bf2f(nb), ain = bf2f(na);
        { const int tn = (t + 1 < L) ? t + 1 : t; const bf16* pn = pr + (size_t)tn * NP; nq = pn[C_DQKV]; nk = pn[C_DQKV + 256]; nv = pn[C_DQKV + 512]; ng = pn[C_DG];
          nb = P[(size_t)tn * NP + C_DBETA + h]; na = P[(size_t)tn * NP + C_DA + h]; }
        float q = siluf_(wq[0] * xq0 + wq[1] * xq1 + wq[2] * xq2 + wq[3] * rq);
        float k = siluf_(wk[0] * xk0 + wk[1] * xk1 + wk[2] * xk2 + wk[3] * rk);
        const float v = siluf_(wv[0] * xv0 + wv[1] * xv1 + wv[2] * xv2 + wv[3] * rv);
        xq0 = xq1; xq1 = xq2; xq2 = rq; xk0 = xk1; xk1 = xk2; xk2 = rk; xv0 = xv1; xv1 = xv2; xv2 = rv;
        q = q * rsqrtf(wave_sum(q * q) + EPS) * 0.125f;
        k = k * rsqrtf(wave_sum(k * k) + EPS);
        const float beta = sigmoidf_(bin);
        const float eg = expf(A * softplusf_(ain + dt_bias));
        scr[lane] = q; scr[64 + lane] = k;
        LDS_WAIT();
        float ks = 0.f;
#pragma unroll
        for (int d = 0; d < 64; ++d) { S[d] *= eg; ks += scr[64 + d] * S[d]; }
        const float vn = beta * (v - ks);
        float o = 0.f;
#pragma unroll
        for (int d = 0; d < 64; ++d) { S[d] += scr[64 + d] * vn; o += scr[d] * S[d]; }
        LDS_WAIT();
        const float ms = wave_sum(o * o) * (1.f / 64.f);
        Y[(size_t)t * D + 256 + h * 64 + lane] = (bf16)f2bf(o * rsqrtf(ms + EPS) * gn * siluf_(gate));
    }
}
__device__ __forceinline__ void task_gla(LAS float* scr, const bf16* P, const float* w_gk  , const float* b_gk, const float* norm_g, bf16* Y, int h, int lane) {
    float S[32];
#pragma unroll
    for (int d = 0; d < 32; ++d) S[d] = 0.f;
    const float gn = norm_g[lane];
    const int dl = lane & 31;
    float wg[16];
#pragma unroll
    for (int r = 0; r < 16; ++r) wg[r] = w_gk[r * 128 + h * 32 + dl];
    const float bg = b_gk[h * 32 + dl];
    const float qs = 0.17677669529663687f;
    for (int t = 0; t < L; ++t) {
        const bf16* pr = P + (size_t)t * NP;
        float z = bg;
#pragma unroll
        for (int r = 0; r < 16; ++r) z += bf2f(pr[C_GCODE + r]) * wg[r];
        const float gk = -softplusf_(-z) * (1.f / 16.f);
        const float qd = bf2f(pr[C_GQ + h * 32 + dl]) * qs, kd = bf2f(pr[C_GK + h * 32 + dl]);
        const float v = bf2f(pr[C_GV + h * 64 + lane]), gate = bf2f(pr[C_GG + h * 64 + lane]);
        if (lane < 32) { scr[dl] = expf(gk); scr[32 + dl] = qd; scr[64 + dl] = kd; }
        LDS_WAIT();
        float o = 0.f;
#pragma unroll
        for (int d = 0; d < 32; ++d) { S[d] = scr[d] * S[d] + scr[64 + d] * v; o += scr[32 + d] * S[d]; }
        LDS_WAIT();
        const float ms = wave_sum(o * o) * (1.f / 64.f);
        Y[(size_t)t * D + 768 + h * 64 + lane] = (bf16)f2bf(o * rsqrtf(ms + EPS) * gn * siluf_(gate));
    }
}
__device__ __forceinline__ void task_s5(bf16* P, const float* coef, const float* c_re, const float* c_im, const float* dd, int g, int lane) {
    const int i = g * 64 + lane;
    const float ar = coef[i], ai = coef[1024 + i];
    float br[16], bi[16], cr[16], ci[16];
#pragma unroll
    for (int h = 0; h < 16; ++h) { br[h] = coef[2048 + i * 16 + h]; bi[h] = coef[2048 + 16384 + i * 16 + h]; cr[h] = c_re[(g * 16 + h) * 64 + lane]; ci[h] = c_im[(g * 16 + h) * 64 + lane]; }
    const float dmy = dd[g * 16 + (lane & 15)];
    float sr = 0.f, si = 0.f;
    for (int t = 0; t < L; ++t) {
        bf16* ur = P + (size_t)t * NP + C_SU + g * 16;
        float u[16];
#pragma unroll
        for (int h = 0; h < 16; ++h) u[h] = bf2f(ur[h]);
        float xr = 0.f, xi = 0.f;
#pragma unroll
        for (int h = 0; h < 16; ++h) { xr += br[h] * u[h]; xi += bi[h] * u[h]; }
        const float nr = ar * sr - ai * si + xr, ni = ar * si + ai * sr + xi;
        sr = nr; si = ni;
        float mine = 0.f, umine = 0.f;
#pragma unroll
        for (int h = 0; h < 16; ++h) { const float tot = wave_sum(cr[h] * sr - ci[h] * si); if ((lane & 15) == h) { mine = tot; umine = u[h]; } }
        if (lane < 16) ur[lane] = (bf16)f2bf(geluf_(mine + dmy * umine));
    }
}

__global__ void __launch_bounds__(NWAVES * 64, 2) hymba_fwd(Args args) {
    extern __shared__ __attribute__((aligned(16))) unsigned char lds[];
    LAS unsigned char* ldsb0 = (LAS unsigned char*)lds;
    volatile LAS unsigned* MISC = (volatile LAS unsigned*)(ldsb0 + MISC_OFF);
    const int tid = threadIdx.x, wave0 = __builtin_amdgcn_readfirstlane(tid >> 6);
    const int G = gridDim.x;
    unsigned char* ws = args.ws;
    gu32* ctl = (gu32*)(ws + WS_CTL);
    for (int u = tid; u < (LDS_BYTES - LDSCTL_OFF) / 4; u += NWAVES * 64) ((LAS unsigned*)(ldsb0 + LDSCTL_OFF))[u] = 0u;
    __syncthreads();
    XcdBarrier bar = xcd_barrier_post((unsigned*)(ctl + CW_BAR), MISC + 8);
#define GRID_BAR() xcd_barrier(bar)
    if (tid == 0) {
#pragma unroll
        for (int k = 0; k < 23; ++k) ((LAS unsigned long long*)(ldsb0 + ARGS_OFF))[k] = (unsigned long long)args.in[k];
        ((LAS unsigned long long*)(ldsb0 + ARGS_OFF))[23] = (unsigned long long)args.out; ((LAS unsigned long long*)(ldsb0 + ARGS_OFF))[24] = (unsigned long long)args.ws;
    }
    __syncthreads();
#define ARGU64(k) ({ const unsigned long long v_ = *(volatile LAS unsigned long long*)(ldsb + ARGS_OFF + 8 * (k)); \
        ((unsigned long long)(unsigned)__builtin_amdgcn_readfirstlane((int)(unsigned)(v_ >> 32)) << 32) | (unsigned)__builtin_amdgcn_readfirstlane((int)(unsigned)v_); })
#define ARGF(k) ((const float*)ARGU64(k))
#define x_in ARGF(0)
#define norm_pre ARGF(1)
#define norm_post ARGF(2)
#define w_in ARGF(3)
#define w_out ARGF(4)
#define ret_norm ARGF(5)
#define dn_conv ARGF(6)
#define dn_a_log ARGF(7)
#define dn_dt_bias ARGF(8)
#define dn_norm ARGF(9)
#define s5_lam_re ARGF(10)
#define s5_lam_im ARGF(11)
#define s5_b_re ARGF(12)
#define s5_b_im ARGF(13)
#define s5_c_re ARGF(14)
#define s5_c_im ARGF(15)
#define s5_d ARGF(16)
#define s5_log_dt ARGF(17)
#define s5_w_glu ARGF(18)
#define s5_b_glu ARGF(19)
#define gla_w_gk ARGF(20)
#define gla_b_gk ARGF(21)
#define gla_norm ARGF(22)
#define X ((float*)ARGU64(23))
#define WSB ((unsigned char*)ARGU64(24))
#define TAB ((f32x2v*)(ws + WS_TAB))
#define COEF ((float*)(ws + WS_COEF))
#define WGLU ((bf16*)(ws + WS_WGLU))
#define WOUT ((bf16*)(ws + WS_WOUT))
#define WIN ((bf16*)(ws + WS_WIN))
#define HY ((bf16*)(ws + WS_HY))
#define P ((bf16*)(ws + WS_P))
#define O32 ((float*)(ws + WS_P))
    const int NGW = G * NWAVES, NGT = G * NWAVES * 64;

#define PHASE_IDS() LAS unsigned char* ldsb_p = ldsb0; asm volatile("" : "+s"(ldsb_p)); LAS unsigned char* const ldsb = ldsb_p; \
        int lane_p, bx_p = blockIdx.x; asm volatile("v_mbcnt_lo_u32_b32 %0, -1, 0\n\tv_mbcnt_hi_u32_b32 %0, -1, %0" : "=v"(lane_p)); asm volatile("" : "+s"(bx_p)); \
        int wave_p = wave0; asm volatile("" : "+s"(wave_p)); const int wave = wave_p; \
        const int lane = lane_p, tid = wave * 64 + lane_p, bx = bx_p, gw = bx * NWAVES + wave, gt = bx * (NWAVES * 64) + tid; unsigned char* const ws = WSB; \
        (void)lane; (void)tid; (void)bx; (void)gw; (void)gt; (void)ws
#define CONVERT_WEIGHTS(wl_) do { \
        LAS float* scr_ = (LAS float*)(ldsb + wave * 16384); const float* wi_ = w_in; const float* wo_ = w_out; const float* wg_ = s5_w_glu; \
        constexpr int I_IN = 16 * 105, I_OUT = 16 * 32, I_GLU = 4 * 8, I_L = I_IN + I_OUT + I_GLU; \
        for (int it_ = gw; it_ < I_L; it_ += NGW) { int r_ = it_; \
            if (r_ < I_IN) { p0_transpose_item(wi_ + (size_t)(wl_) * D * NC, D, NC, WIN, scr_, r_, lane); continue; } r_ -= I_IN; \
            if (r_ < I_OUT) { p0_transpose_item(wo_ + (size_t)(wl_) * D * D, D, D, WOUT, scr_, r_, lane); continue; } r_ -= I_OUT; \
            p0_transpose_item(wg_ + (size_t)(wl_) * 65536, 256, 256, WGLU, scr_, r_, lane); } \
    } while (0)
    {
        PHASE_IDS();
        CONVERT_WEIGHTS(0);
        for (int it = gt; it < 224 * 128; it += NGT) ((GAS v4u*)(WIN + (size_t)3360 * D))[it] = (v4u){0u, 0u, 0u, 0u};
        const float* xin_ = x_in; float* xout_ = X; const float* npre_ = norm_pre;
        for (int m = gw; m < M; m += NGW) {
            const GAS f32x4* xr = (const GAS f32x4*)(xin_ + (size_t)m * D) + lane; GAS f32x4* xo = (GAS f32x4*)(xout_ + (size_t)m * D) + lane;
            f32x4 v[4]; float s = 0.f;
#pragma unroll
            for (int j = 0; j < 4; ++j) { v[j] = xr[64 * j]; xo[64 * j] = v[j]; s += (v[j].x * v[j].x + v[j].y * v[j].y) + (v[j].z * v[j].z + v[j].w * v[j].w); }
            const float rstd = rsqrtf(wave_sum(s) * (1.f / D) + EPS);
            GAS unsigned long long* o8 = (GAS unsigned long long*)(HY + (size_t)m * D) + lane;
#pragma unroll
            for (int j = 0; j < 4; ++j) { const f32x4 gg = ((const GAS f32x4*)npre_)[lane + 64 * j];
                o8[64 * j] = (unsigned long long)pk2(v[j].x * rstd * gg.x, v[j].y * rstd * gg.y) | ((unsigned long long)pk2(v[j].z * rstd * gg.z, v[j].w * rstd * gg.w) << 32); }
        }
        for (int it = gt; it < L * 32; it += NGT) { const int t = it >> 5, i = it & 31; const float inv = powf(10000.f, -(float)(2 * i) / 64.f); float sn, cs; sincosf((float)t * inv, &sn, &cs); TAB[it] = (f32x2v){cs, sn}; }
        {
            const float* ldt_ = s5_log_dt; const float* lre_ = s5_lam_re; const float* lim_ = s5_lam_im; const float* bre_ = s5_b_re; const float* bim_ = s5_b_im;
            const float* cre_ = s5_c_re; const float* cim_ = s5_c_im;
            for (int it = gt; it < DEPTH * 2 * 65536; it += NGT) { const int l = it >> 17, r = it & 131071; ((GAS v4u*)(ws + WS_S5_MAT + (size_t)l * S5_MAT_LAYER + S5_KM_OFF))[r] = (v4u){0u, 0u, 0u, 0u}; }
            for (int it = gt; it < DEPTH * 1024; it += NGT) {
                const int l = it >> 10, i = it & 1023, g = i >> 6, p = i & 63;
                const float dt = expf(ldt_[l * 16 + g]);
                const float lr = lre_[it], li = lim_[it];
                const float mag = expf(lr * dt), ang = li * dt;
                const float ar = mag * cosf(ang), ai = mag * sinf(ang);
                const float den = lr * lr + li * li, nr = ar - 1.f, ni = ai;
                const float cr = (nr * lr + ni * li) / den, ci = (ni * lr - nr * li) / den;
                float* cf = COEF + (size_t)l * COEF_STRIDE;
                cf[i] = ar; cf[1024 + i] = ai;
                float bbr[16], bbi[16];
#pragma unroll
                for (int h = 0; h < 16; ++h) { const float br = bre_[(size_t)it * 16 + h], bi = bim_[(size_t)it * 16 + h];
                    bbr[h] = cr * br - ci * bi; bbi[h] = cr * bi + ci * br; cf[2048 + i * 16 + h] = bbr[h]; cf[2048 + 16384 + i * 16 + h] = bbi[h]; }
                unsigned char* mats = ws + WS_S5_MAT + (size_t)l * S5_MAT_LAYER;
                bf16* em = (bf16*)(mats + S5_EM_OFF) + (size_t)g * 128 * 256; bf16* cm = (bf16*)(mats + S5_CM_OFF) + (size_t)g * 256 * 128;
                float* apow = (float*)(ws + WS_S5_APOW) + ((size_t)(l * 16 + g) * 16 * 64) * 2;
                float pr = 1.f, pi = 0.f;
#pragma unroll 1
                for (int m = 0; m <= 16; ++m) {
                    if (m < 16) {
                        apow[(m * 64 + p) * 2] = pr; apow[(m * 64 + p) * 2 + 1] = pi;
                        const int j = 15 - m;
                        float er[16], ei[16];
#pragma unroll
                        for (int h = 0; h < 16; ++h) { er[h] = pr * bbr[h] - pi * bbi[h]; ei[h] = pr * bbi[h] + pi * bbr[h]; }
                        GAS v4u* d0 = (GAS v4u*)(em + (size_t)p * 256 + j * 16); GAS v4u* d1 = (GAS v4u*)(em + (size_t)(64 + p) * 256 + j * 16);
                        d0[0] = (v4u){pk2(er[0], er[1]), pk2(er[2], er[3]), pk2(er[4], er[5]), pk2(er[6], er[7])}; d0[1] = (v4u){pk2(er[8], er[9]), pk2(er[10], er[11]), pk2(er[12], er[13]), pk2(er[14], er[15])};
                        d1[0] = (v4u){pk2(ei[0], ei[1]), pk2(ei[2], ei[3]), pk2(ei[4], ei[5]), pk2(ei[6], ei[7])}; d1[1] = (v4u){pk2(ei[8], ei[9]), pk2(ei[10], ei[11]), pk2(ei[12], ei[13]), pk2(ei[14], ei[15])};
                    } else { float* a16 = (float*)(ws + WS_S5_APOW + 768 * 1024) + ((size_t)(l * 16 + g) * 64 + p) * 2; a16[0] = pr; a16[1] = pi; }
                    if (m >= 1) { const int ii = m - 1;
#pragma unroll 4
                        for (int h = 0; h < 16; ++h) { const float c_r = cre_[((size_t)(l * 16 + g) * 16 + h) * 64 + p], c_i = cim_[((size_t)(l * 16 + g) * 16 + h) * 64 + p];
                            cm[(size_t)(ii * 16 + h) * 128 + p] = (bf16)f2bf(c_r * pr - c_i * pi); cm[(size_t)(ii * 16 + h) * 128 + 64 + p] = (bf16)f2bf(-(c_r * pi + c_i * pr)); } }
                    const float npr = pr * ar - pi * ai, npi = pr * ai + pi * ar; pr = npr; pi = npi;
                }
            }
        }
    }
    GRID_BAR();
    {
        PHASE_IDS();
        const float* cre_ = s5_c_re; const float* cim_ = s5_c_im; const float* dd_ = s5_d;
        for (int it = gt; it < DEPTH * 16 * 16 * 256; it += NGT) {
            const int l = it >> 16, g = (it >> 12) & 15, d = (it >> 8) & 15, h = (it >> 4) & 15, hp = it & 15;
            const float* cf = COEF + (size_t)l * COEF_STRIDE;
            const float* apow = (const float*)(ws + WS_S5_APOW) + ((size_t)((l * 16 + g) * 16 + d) * 64) * 2;
            const float* crp = cre_ + ((size_t)(l * 16 + g) * 16 + h) * 64; const float* cip = cim_ + ((size_t)(l * 16 + g) * 16 + h) * 64;
            float acc = 0.f;
#pragma unroll 4
            for (int p = 0; p < 64; ++p) { const float pr = apow[2 * p], pi = apow[2 * p + 1], br = cf[2048 + (g * 64 + p) * 16 + hp], bi = cf[2048 + 16384 + (g * 64 + p) * 16 + hp];
                const float zr = pr * br - pi * bi, zi = pr * bi + pi * br;
                acc += crp[p] * zr - cip[p] * zi; }
            if (d == 0 && h == hp) acc += dd_[(l * 16 + g) * 16 + h];
            bf16* km = (bf16*)(ws + WS_S5_MAT + (size_t)l * S5_MAT_LAYER + S5_KM_OFF) + (size_t)g * 256 * 256;
            const bf16 v = (bf16)f2bf(acc);
            for (int j = 0; j + d < 16; ++j) km[(size_t)((j + d) * 16 + h) * 256 + j * 16 + hp] = v;
        }
    }
    GRID_BAR();

#pragma nounroll
    for (int l = 0; l < DEPTH; ++l) {
        {
            PHASE_IDS();
            pg8::Gemm g{HY, WIN, M, NP, D, D, D}; pg8::StaticOrder S; S.init(M, NP, G, bx);
            pg8::EpiStoreBf16 E{P, NP};
            pg8::gemm_phase<pg8::EpiStoreBf16, pg8::StaticOrder, true, true, D, D, D>(ldsb, g, S, E, tid);
        }
        GRID_BAR();
        {
            PHASE_IDS();
            LAS unsigned char* wl = ldsb + wave * mx::WLDS;
            const DnBufs dnb{(bf16*)(ws + WS_DN_WF), (bf16*)(ws + WS_DN_KGF), (bf16*)(ws + WS_DN_UF), (bf16*)(ws + WS_DN_QN), (bf16*)(ws + WS_DN_KN), (float*)(ws + WS_DN_G), (float*)(ws + WS_DN_GL)};
            for (int it = gw; it < 3584; it += NGW) {
                int lane_i = lane_p; asm volatile("" : "+v"(lane_i)); const int lane = lane_i;
                if (it < 3072) {
                    const int ii = it & 1023, bh = ii >> 7, n = ii & 127, b = bh >> 2, h = bh & 3;
                    const size_t t0 = (size_t)(b * L + n * 64);
                    bf16* Pt = P + t0 * NP;
                    if (it < 1024) dn_A(wl, Pt, t0, n, h, ii, dn_conv + (size_t)l * 4 * 768, dn_a_log[l * 4 + h], dn_dt_bias[l * 4 + h], dnb, lane);
                    else if (it < 2048) ret_A(wl, Pt, TAB, n * 64, h, (float*)(ws + WS_RET_KV) + (size_t)ii * 4096, lane);
                    else gla_A(wl, Pt, gla_w_gk + (size_t)l * 16 * 128, gla_b_gk + l * 128, h, (float*)(ws + WS_GLA_KV) + (size_t)ii * 2048, (float*)(ws + WS_GLA_DEC) + (size_t)ii * 32, lane);
                } else { const int i5 = it - 3072; s5_item<false>(P + C_SU, ws + WS_S5_MAT + (size_t)l * S5_MAT_LAYER, (float*)(ws + WS_S5_E), nullptr, i5 & 15, i5 >> 4, lane); }
            }
        }
        GRID_BAR();
        {
            PHASE_IDS();
            if (bx >= 96 && bx < 128) { const int b = (bx - 96) >> 4, g = (bx - 96) & 15;
                s5_scan_block((LAS float*)ldsb, (const float*)(ws + WS_S5_E) + (size_t)b * 512 * 2048, (bf16*)(ws + WS_S5_SP) + (size_t)b * 512 * 2048,
                              (const float*)(ws + WS_S5_APOW + 768 * 1024) + ((size_t)(l * 16 + g) * 64) * 2, g, tid); }
            else if (wave == 0) {
                if (bx < 64) { const int bh = bx >> 3, sub = bx & 7; const float g64 = exp2f(64.f * log2f(1.f - exp2f(-5.f - (float)(bh & 3))));
                    la_scan<2>((const float*)(ws + WS_RET_KV) + (size_t)bh * 128 * 4096, (bf16*)(ws + WS_RET_RP) + (size_t)bh * 128 * 4096, nullptr, g64, sub, lane); }
                else if (bx < 96) { const int bh = (bx - 64) >> 2, sub = (bx - 64) & 3;
                    la_scan<1>((const float*)(ws + WS_GLA_KV) + (size_t)bh * 128 * 2048, (bf16*)(ws + WS_GLA_RP) + (size_t)bh * 128 * 2048, (const float*)(ws + WS_GLA_DEC) + (size_t)bh * 128 * 32, 0.f, sub, lane); }
                else if (bx >= 128 && bx < 160) { const int bh = (bx - 128) >> 2, slc = (bx - 128) & 3;
                    dn_scan((const bf16*)(ws + WS_DN_WF), (const bf16*)(ws + WS_DN_KGF), (const bf16*)(ws + WS_DN_UF), (const float*)(ws + WS_DN_GL), (bf16*)(ws + WS_DN_SPF), (bf16*)(ws + WS_DN_VNF), bh, slc, lane); }
            }
        }
        GRID_BAR();
        {
            PHASE_IDS();
            LAS unsigned char* wl = ldsb + wave * mx::WLDS;
            for (int it = gw; it < 3584; it += NGW) {
                int lane_i = lane_p; asm volatile("" : "+v"(lane_i)); const int lane = lane_i;
                if (it < 3072) {
                    const int ii = it & 1023, bh = ii >> 7, n = ii & 127, b = bh >> 2, h = bh & 3;
                    const size_t t0 = (size_t)(b * L + n * 64);
                    const bf16* Pt = P + t0 * NP;
                    if (it < 1024) dn_out(wl, (const bf16*)(ws + WS_DN_QN) + t0 * 256 + h * 64, (const bf16*)(ws + WS_DN_KN) + t0 * 256 + h * 64, (const float*)(ws + WS_DN_G) + t0 * 4 + h,
                                          (const bf16*)(ws + WS_DN_SPF) + (size_t)ii * 4096, (const bf16*)(ws + WS_DN_VNF) + (size_t)ii * 4096, Pt + C_DG + h * 64, NP, dn_norm + l * 64, HY + t0 * D + 256 + h * 64, D, lane);
                    else if (it < 2048) mx::la_out<64>(wl, Pt + C_RQ + h * 64, Pt + C_RK + h * 64, NP, Pt + C_RV + h * 64, Pt + C_RG + h * 64, NP,
                                              (const bf16*)(ws + WS_RET_RP) + (size_t)ii * 4096, ret_norm + l * 64, HY + t0 * D + 0 + h * 64, D, lane);
                    else mx::la_out<32>(wl, Pt + C_GQ + h * 32, Pt + C_GK + h * 32, NP, Pt + C_GV + h * 64, Pt + C_GG + h * 64, NP,
                                    (const bf16*)(ws + WS_GLA_RP) + (size_t)ii * 2048, gla_norm + l * 64, HY + t0 * D + 768 + h * 64, D, lane);
                } else { const int i5 = it - 3072; s5_item<true>(P + C_SU, ws + WS_S5_MAT + (size_t)l * S5_MAT_LAYER, nullptr, (const bf16*)(ws + WS_S5_SP), i5 & 15, i5 >> 4, lane); }
            }
        }
        GRID_BAR();
        {
            PHASE_IDS();
            pg8::Gemm g{P + C_SU, WGLU, M, 256, 256, NP, 256}; pg8::StaticOrder S; S.init(M, 256, G, bx);
            pg8::EpiGlu E{P + C_SU, P + C_SG, NP, s5_b_glu + l * 256, HY + 512, D};
            pg8::gemm_phase<pg8::EpiGlu, pg8::StaticOrder, true, true, 256, NP, 256>(ldsb, g, S, E, tid);
        }
        GRID_BAR();
        {
            PHASE_IDS();
            pg8::Gemm g{HY, WOUT, M, D, D, D, D}; pg8::StaticOrder S; S.init(M, D, G, bx);
            pg8::EpiStoreF32 E{O32, D};
            pg8::gemm_phase<pg8::EpiStoreF32, pg8::StaticOrder, true, true, D, D, D>(ldsb, g, S, E, tid);
        }
        GRID_BAR();
        {
            PHASE_IDS();
            if (l + 1 < DEPTH) CONVERT_WEIGHTS(l + 1);
            float* xout_ = X; const float* npost_ = norm_post + l * D; const float* npre_ = norm_pre + (l + 1 < DEPTH ? l + 1 : l) * D;
            for (int m = gw; m < M; m += NGW) {
                const GAS f32x4* orow = (const GAS f32x4*)(O32 + (size_t)m * D) + lane; GAS f32x4* xr = (GAS f32x4*)(xout_ + (size_t)m * D) + lane;
                f32x4 o[4], xv[4]; float s = 0.f;
#pragma unroll
                for (int j = 0; j < 4; ++j) { o[j] = orow[64 * j]; xv[j] = xr[64 * j]; s += (o[j].x * o[j].x + o[j].y * o[j].y) + (o[j].z * o[j].z + o[j].w * o[j].w); }
                const float rstd = rsqrtf(wave_sum(s) * (1.f / D) + EPS);
                float s2 = 0.f;
#pragma unroll
                for (int j = 0; j < 4; ++j) { const f32x4 gg = ((const GAS f32x4*)npost_)[lane + 64 * j];
                    xv[j].x += o[j].x * rstd * gg.x; xv[j].y += o[j].y * rstd * gg.y; xv[j].z += o[j].z * rstd * gg.z; xv[j].w += o[j].w * rstd * gg.w;
                    xr[64 * j] = xv[j]; s2 += (xv[j].x * xv[j].x + xv[j].y * xv[j].y) + (xv[j].z * xv[j].z + xv[j].w * xv[j].w); }
                if (l + 1 < DEPTH) {
                    const float r2 = rsqrtf(wave_sum(s2) * (1.f / D) + EPS);
                    GAS unsigned long long* o8 = (GAS unsigned long long*)(HY + (size_t)m * D) + lane;
#pragma unroll
                    for (int j = 0; j < 4; ++j) { const f32x4 gg = ((const GAS f32x4*)npre_)[lane + 64 * j];
                        o8[64 * j] = (unsigned long long)pk2(xv[j].x * r2 * gg.x, xv[j].y * r2 * gg.y) | ((unsigned long long)pk2(xv[j].z * r2 * gg.z, xv[j].w * r2 * gg.w) << 32); }
                }
            }
        }
        if (l + 1 < DEPTH) GRID_BAR();
    }
}

extern "C" void kernel_launch(void* const* d_in, const int* in_sizes, int n_in, void* d_out, int out_size, void* d_ws, size_t ws_size, hipStream_t stream) {
    static int grid = 0;
    if (grid == 0) {
        if (n_in != 23 || out_size != M * D || ws_size < WS_END) { fprintf(stderr, "kernel_launch: unexpected shapes (n_in %d out %d ws %zu)\n", n_in, out_size, ws_size); grid = -1; return; }
        int dev = 0, cus = 0, per_cu = 0;
        if (hipGetDevice(&dev) != hipSuccess || hipDeviceGetAttribute(&cus, hipDeviceAttributeMultiprocessorCount, dev) != hipSuccess) { grid = -1; return; }
        if (hipFuncSetAttribute((const void*)hymba_fwd, hipFuncAttributeMaxDynamicSharedMemorySize, LDS_BYTES) != hipSuccess) { fprintf(stderr, "kernel_launch: hipFuncSetAttribute failed\n"); grid = -1; return; }
        if (hipOccupancyMaxActiveBlocksPerMultiprocessor(&per_cu, (const void*)hymba_fwd, NWAVES * 64, LDS_BYTES) != hipSuccess || per_cu < 1) { fprintf(stderr, "kernel_launch: occupancy query says %d blocks/CU\n", per_cu); grid = -1; return; }
        grid = cus;
    }
    if (grid < 0) return;
    (void)hipMemsetAsync((char*)d_ws + WS_CTL, 0, CTL_ZERO_BYTES, stream);
    Args a{};
    for (int i = 0; i < 23; ++i) a.in[i] = (const float*)d_in[i];
    a.out = (float*)d_out; a.ws = (unsigned char*)d_ws;
    void* kargs[] = {&a};
    const hipError_t e = hipLaunchCooperativeKernel((const void*)hymba_fwd, dim3(grid), dim3(NWAVES * 64), kargs, LDS_BYTES, stream);
    if (e != hipSuccess) fprintf(stderr, "cooperative launch failed: %s (grid %d)\n", hipGetErrorString(e), grid);
}
```

```cpp
#include <hip/hip_runtime.h>
#include <cstdio>
#include <cstdint>
#include <math.h>
#ifndef CH_RET
#define CH_RET 1
#endif
#ifndef CH_GLA
#define CH_GLA 1
#endif
#ifndef CH_S5
#define CH_S5 1
#endif
#ifndef CH_DN
#define CH_DN 1
#endif
namespace pg8 {
#define PG8_LAS __attribute__((address_space(3)))
typedef unsigned short bf16_t;
typedef short bf16x8 __attribute__((ext_vector_type(8)));
typedef float f32x4 __attribute__((ext_vector_type(4)));
typedef unsigned u32x4 __attribute__((ext_vector_type(4)));
constexpr int BM = 256, BK = 64, HALF = 128, HTB = HALF * BK * 2  , STAGE_BYTES = 8 * HTB, NXCD = 8, WGM = 8;

__host__ __device__ __forceinline__ int lds_byte(int r, int c) { const int st = (r >> 4) * 2 + (c >> 5), rr = r & 15, cc = c & 31, ob = rr * 64 + cc * 2; return st * 1024 + (ob ^ (((ob >> 9) & 1) << 5)); }
__host__ __device__ __forceinline__ void stage_rc(int b, int& R, int& C) { const int st = b / 1024, sb = b % 1024, swz = sb ^ (((sb >> 9) & 1) << 5); R = (st >> 1) * 16 + swz / 64; C = (st & 1) * 32 + (swz % 64) / 2; }
__host__ __device__ __forceinline__ int perm32(int rho) { const int n = rho >> 4, i = rho & 15; return 8 * (i >> 2) + 4 * n + (i & 3); }

struct Unit { int pm, pn; };
struct Gemm { const bf16_t* A; const bf16_t* Bt; int M, N, K, lda, ldb; };

struct StaticOrder {
    int nM, nN, nwg, G, c;
    __host__ __device__ void init(int M, int N, int G_, int c_) { nM = M / BM; nN = N / BM; nwg = nM * nN; G = G_; c = c_; }
    __host__ __device__ bool next(int i, Unit& u) const {
        const long L = (long)i * G + c; if (L >= nwg) return false;
        int wgid = (int)L; { const int q = nwg / NXCD, r = nwg % NXCD, xcd = wgid % NXCD, off = wgid / NXCD; wgid = (xcd < r ? xcd * (q + 1) : r * (q + 1) + (xcd - r) * q) + off; }
        const int nig = WGM * nN, gid = wgid / nig, fm = gid * WGM, gsz = (nM - fm) < WGM ? (nM - fm) : WGM;
        u.pm = fm + ((wgid % nig) % gsz); u.pn = (wgid % nig) / gsz; return true;
    }
    __device__ __forceinline__ void a_ready(const Unit&) const {}
    __device__ __forceinline__ void done(const Unit&) const {}
};

__device__ __forceinline__ unsigned cvt_pk_bf16(float lo, float hi) { unsigned r; asm volatile("v_cvt_pk_bf16_f32 %0, %1, %2" : "=v"(r) : "v"(lo), "v"(hi)); return r; }
__device__ __forceinline__ float bf_lo(unsigned w) { return __builtin_bit_cast(float, w << 16); }
__device__ __forceinline__ float bf_hi(unsigned w) { return __builtin_bit_cast(float, w & 0xffff0000u); }
struct EpiStoreBf16 {
    static constexpr bool PERM = true, AFTER_DRAIN = false;
    bf16_t* O; int ldc;
    __device__ __forceinline__ void operator()(const f32x4 (&acc)[2][2][4][2], const Unit& u, int wr, int wc, int fr, int fq) const {
        const int row0 = u.pm * BM + wr * 64 + fr, col0 = u.pn * BM + wc * 32 + 8 * fq;
#pragma unroll
        for (int ai = 0; ai < 2; ++ai)
#pragma unroll
            for (int m = 0; m < 4; ++m) { bf16_t* rowp = O + (size_t)(row0 + ai * HALF + m * 16) * ldc + col0;
#pragma unroll
                for (int bj = 0; bj < 2; ++bj) { const f32x4 v0 = acc[ai][bj][m][0], v1 = acc[ai][bj][m][1];
                    u32x4 w; w.x = cvt_pk_bf16(v0[0], v0[1]); w.y = cvt_pk_bf16(v0[2], v0[3]); w.z = cvt_pk_bf16(v1[0], v1[1]); w.w = cvt_pk_bf16(v1[2], v1[3]);
                    *(u32x4*)(rowp + bj * HALF) = w; } }
    }
};
struct EpiStoreF32 {
    static constexpr bool PERM = false, AFTER_DRAIN = false;
    float* C; int ldc;
    __device__ __forceinline__ void operator()(const f32x4 (&acc)[2][2][4][2], const Unit& u, int wr, int wc, int fr, int fq) const {
        const int row0 = u.pm * BM + wr * 64 + fr, col0 = u.pn * BM + wc * 32 + 4 * fq;
#pragma unroll
        for (int ai = 0; ai < 2; ++ai)
#pragma unroll
            for (int m = 0; m < 4; ++m) { float* rowp = C + (size_t)(row0 + ai * HALF + m * 16) * ldc + col0;
#pragma unroll
                for (int bj = 0; bj < 2; ++bj)
#pragma unroll
                    for (int n = 0; n < 2; ++n) *(f32x4*)(rowp + bj * HALF + n * 16) = acc[ai][bj][m][n]; }
    }
};
struct EpiGlu {
    static constexpr bool PERM = true, AFTER_DRAIN = false;
    const bf16_t* YG; const bf16_t* SG; int ldp; const float* bias; bf16_t* O; int ldo;
    __device__ __forceinline__ void operator()(const f32x4 (&acc)[2][2][4][2], const Unit& u, int wr, int wc, int fr, int fq) const {
        const int row0 = u.pm * BM + wr * 64 + fr, col0 = u.pn * BM + wc * 32 + 8 * fq;
#pragma unroll
        for (int ai = 0; ai < 2; ++ai)
#pragma unroll
            for (int m = 0; m < 4; ++m) { const size_t r = (size_t)(row0 + ai * HALF + m * 16);
#pragma unroll
                for (int bj = 0; bj < 2; ++bj) { const int c = col0 + bj * HALF;
                    const u32x4 yw = *(const u32x4*)(YG + r * ldp + c), gw = *(const u32x4*)(SG + r * ldp + c);
                    const f32x4 b0 = *(const f32x4*)(bias + c), b1 = *(const f32x4*)(bias + c + 4);
                    const f32x4 v0 = acc[ai][bj][m][0] + b0, v1 = acc[ai][bj][m][1] + b1;
                    float z[8] = {v0[0], v0[1], v0[2], v0[3], v1[0], v1[1], v1[2], v1[3]};
                    float yv[8] = {bf_lo(yw.x), bf_hi(yw.x), bf_lo(yw.y), bf_hi(yw.y), bf_lo(yw.z), bf_hi(yw.z), bf_lo(yw.w), bf_hi(yw.w)};
                    float gv[8] = {bf_lo(gw.x), bf_hi(gw.x), bf_lo(gw.y), bf_hi(gw.y), bf_lo(gw.z), bf_hi(gw.z), bf_lo(gw.w), bf_hi(gw.w)};
                    float o[8];
#pragma unroll
                    for (int e = 0; e < 8; ++e) { const float sz = 1.f / (1.f + __expf(-z[e])), sg = gv[e] / (1.f + __expf(-gv[e])); o[e] = yv[e] * sz * sg; }
                    u32x4 w; w.x = cvt_pk_bf16(o[0], o[1]); w.y = cvt_pk_bf16(o[2], o[3]); w.z = cvt_pk_bf16(o[4], o[5]); w.w = cvt_pk_bf16(o[6], o[7]);
                    *(u32x4*)(O + r * ldo + c) = w; } }
    }
};

template <class Epi, class Sched, bool ALIGN_EPI, bool SP2, int KK, int LDA, int LDB>
__device__ __forceinline__ void gemm_phase(PG8_LAS unsigned char* lds, const Gemm g, const Sched& S, const Epi& E, int tid_in) {
    int tid_ = tid_in; asm volatile("" : "+v"(tid_));
    const int tid = tid_, wid = __builtin_amdgcn_readfirstlane(tid >> 6), lane = tid & 63, wr = wid >> 2, wc = wid & 3, fr = lane & 15, fq = lane >> 4;
    constexpr int K = KK, nt = K / BK;
    unsigned voffA[2], voffB[2];
#pragma unroll
    for (int i = 0; i < 2; ++i) { int R, C; stage_rc(tid * 16 + i * 8192, R, C); const int Rb = Epi::PERM ? ((R & ~31) + perm32(R & 31)) : R;
        voffA[i] = (unsigned)(R * LDA + C) * 2u; voffB[i] = (unsigned)(Rb * LDB + C) * 2u; }
    constexpr size_t kstep = (size_t)(BK * 2);
    constexpr size_t hstepA = (size_t)HALF * LDA * 2, hstepB = (size_t)HALF * LDB * 2;
    constexpr size_t tstepA = 2 * hstepA, tstepB = 2 * hstepB;
    const unsigned ldsw = (unsigned)wid * 1024u;
    const int aoff = lds_byte(wr * 64 + fr, fq * 8), boff = lds_byte(wc * 32 + fr, fq * 8);
#define PG8_SA(b, h) (((b) * 2 + (h)) * HTB)
#define PG8_SB(b, h) ((4 + (b) * 2 + (h)) * HTB)
#define PG8_STAGE(bufoff, gbase, voff) do { _Pragma("unroll") for (int _i = 0; _i < 2; ++_i) \
        __builtin_amdgcn_global_load_lds((const unsigned*)((const char*)(gbase) + (voff)[_i]), (PG8_LAS unsigned*)(lds + (bufoff) + ldsw + _i * 8192), 16, 0, 0); } while (0)
#define PG8_LDA(dst, b, h) do { _Pragma("unroll") for (int m = 0; m < 4; ++m) _Pragma("unroll") for (int k = 0; k < 2; ++k) dst[m][k] = *(const PG8_LAS bf16x8*)(lds + PG8_SA(b, h) + aoff + m * 2048 + k * 1024); } while (0)
#define PG8_LDB(dst, b, h) do { _Pragma("unroll") for (int n = 0; n < 2; ++n) _Pragma("unroll") for (int k = 0; k < 2; ++k) dst[n][k] = *(const PG8_LAS bf16x8*)(lds + PG8_SB(b, h) + boff + n * 2048 + k * 1024); } while (0)
#define PG8_MMA(ai, bj, At, Bt) do { __builtin_amdgcn_s_setprio(1); _Pragma("unroll") for (int m = 0; m < 4; ++m) _Pragma("unroll") for (int n = 0; n < 2; ++n) _Pragma("unroll") for (int k = 0; k < 2; ++k) \
        acc[ai][bj][m][n] = __builtin_amdgcn_mfma_f32_16x16x32_bf16(Bt[n][k], At[m][k], acc[ai][bj][m][n], 0, 0, 0); __builtin_amdgcn_s_setprio(0); } while (0)
#define PG8_WAIT_V(n) asm volatile("s_waitcnt vmcnt(" #n ")" ::: "memory")
#define PG8_WAIT_L(n) asm volatile("s_waitcnt lgkmcnt(" #n ")" ::: "memory")
#define PG8_BAR __builtin_amdgcn_s_barrier()
#define PG8_SCHED __builtin_amdgcn_sched_barrier(0)
    Unit cur, nxt; int ui = 0;
    if (!S.next(0, cur)) return;
    f32x4 acc[2][2][4][2];
#pragma unroll
    for (int a = 0; a < 2; ++a)
#pragma unroll
        for (int b = 0; b < 2; ++b)
#pragma unroll
            for (int m = 0; m < 4; ++m)
#pragma unroll
                for (int n = 0; n < 2; ++n) acc[a][b][m][n] = (f32x4){0.f, 0.f, 0.f, 0.f};
    bf16x8 At[4][2], B0[2][2], B1[2][2];
    const char* cA = (const char*)g.A + (size_t)cur.pm * tstepA; const char* cB = (const char*)g.Bt + (size_t)cur.pn * tstepB;
    S.a_ready(cur);
    if constexpr (SP2) {
        PG8_STAGE(PG8_SB(0, 0), cB, voffB); PG8_STAGE(PG8_SB(0, 1), cB + hstepB, voffB); PG8_STAGE(PG8_SA(0, 0), cA, voffA); PG8_STAGE(PG8_SA(0, 1), cA + hstepA, voffA);
        if (wr == 1) PG8_BAR;
        PG8_WAIT_V(2); PG8_BAR;
        PG8_STAGE(PG8_SB(1, 0), cB + kstep, voffB); PG8_STAGE(PG8_SA(1, 0), cA + kstep, voffA); PG8_STAGE(PG8_SB(1, 1), cB + hstepB + kstep, voffB);
        PG8_WAIT_V(6); PG8_BAR;
    } else {
        PG8_STAGE(PG8_SB(0, 0), cB, voffB); PG8_STAGE(PG8_SA(0, 0), cA, voffA); PG8_STAGE(PG8_SB(0, 1), cB + hstepB, voffB); PG8_STAGE(PG8_SA(0, 1), cA + hstepA, voffA);
        if (wr == 1) PG8_BAR;
        PG8_WAIT_V(4); PG8_BAR;
        PG8_STAGE(PG8_SB(1, 0), cB + kstep, voffB); PG8_STAGE(PG8_SA(1, 0), cA + kstep, voffA); PG8_STAGE(PG8_SB(1, 1), cB + hstepB + kstep, voffB);
        PG8_WAIT_V(6); PG8_BAR;
    }
    for (;;) {
        const bool has_next = S.next(ui + 1, nxt);
        const char* nA = has_next ? (const char*)g.A + (size_t)nxt.pm * tstepA : cA; const char* nB = has_next ? (const char*)g.Bt + (size_t)nxt.pn * tstepB : cB;
        for (int t = 0; t < nt; t += 2) {
            const bool last = (t == nt - 2);
            const char* a1 = cA + (size_t)(t + 1) * kstep;
            const char* a2 = last ? nA : cA + (size_t)(t + 2) * kstep; const char* b2 = last ? nB : cB + (size_t)(t + 2) * kstep;
            const char* a3 = a2 + kstep; const char* b3 = b2 + kstep;
            if (last && has_next) S.a_ready(nxt);
            if constexpr (SP2) {
            PG8_LDB(B0, 0, 0); PG8_LDB(B1, 0, 1); PG8_SCHED; PG8_LDA(At, 0, 0); PG8_STAGE(PG8_SA(1, 1), a1 + hstepA, voffA);
            PG8_WAIT_V(8); PG8_WAIT_L(0); PG8_BAR; PG8_MMA(0, 0, At, B0); PG8_MMA(0, 1, At, B1); PG8_BAR; PG8_SCHED;
            PG8_LDA(At, 0, 1); PG8_STAGE(PG8_SB(0, 0), b2, voffB); PG8_STAGE(PG8_SB(0, 1), b2 + hstepB, voffB); PG8_STAGE(PG8_SA(0, 0), a2, voffA);
            PG8_WAIT_V(8); PG8_WAIT_L(0); PG8_BAR; PG8_MMA(1, 0, At, B0); PG8_MMA(1, 1, At, B1); PG8_BAR; PG8_SCHED;
            PG8_LDB(B0, 1, 0); PG8_LDB(B1, 1, 1); PG8_SCHED; PG8_LDA(At, 1, 0); PG8_STAGE(PG8_SA(0, 1), a2 + hstepA, voffA);
            PG8_WAIT_V(8); PG8_WAIT_L(0); PG8_BAR; PG8_MMA(0, 0, At, B0); PG8_MMA(0, 1, At, B1); PG8_BAR; PG8_SCHED;
            PG8_LDA(At, 1, 1); PG8_STAGE(PG8_SB(1, 0), b3, voffB); PG8_STAGE(PG8_SB(1, 1), b3 + hstepB, voffB); PG8_STAGE(PG8_SA(1, 0), a3, voffA);
            PG8_WAIT_V(8); PG8_WAIT_L(0); PG8_BAR; PG8_MMA(1, 0, At, B0); PG8_MMA(1, 1, At, B1); PG8_BAR; PG8_SCHED;
            } else {
            PG8_LDB(B0, 0, 0); PG8_SCHED; PG8_LDA(At, 0, 0); PG8_STAGE(PG8_SA(1, 1), a1 + hstepA, voffA);
            PG8_WAIT_L(8); PG8_BAR; PG8_WAIT_L(0); PG8_MMA(0, 0, At, B0); PG8_BAR; PG8_SCHED;
            PG8_LDB(B1, 0, 1); PG8_STAGE(PG8_SB(0, 0), b2, voffB);
            PG8_BAR; PG8_WAIT_L(0); PG8_MMA(0, 1, At, B1); PG8_BAR;
            PG8_LDA(At, 0, 1); PG8_STAGE(PG8_SA(0, 0), a2, voffA);
            PG8_BAR; PG8_WAIT_L(0); PG8_MMA(1, 0, At, B0); PG8_BAR; PG8_SCHED;
            PG8_STAGE(PG8_SB(0, 1), b2 + hstepB, voffB);
            PG8_WAIT_V(6); PG8_BAR; PG8_MMA(1, 1, At, B1); PG8_BAR;
            PG8_LDB(B0, 1, 0); PG8_SCHED; PG8_LDA(At, 1, 0); PG8_STAGE(PG8_SA(0, 1), a2 + hstepA, voffA);
            PG8_WAIT_L(8); PG8_BAR; PG8_WAIT_L(0); PG8_MMA(0, 0, At, B0); PG8_BAR; PG8_SCHED;
            PG8_LDB(B1, 1, 1); PG8_STAGE(PG8_SB(1, 0), b3, voffB);
            PG8_BAR; PG8_WAIT_L(0); PG8_MMA(0, 1, At, B1); PG8_BAR;
            PG8_LDA(At, 1, 1); PG8_STAGE(PG8_SA(1, 0), a3, voffA);
            PG8_BAR; PG8_WAIT_L(0); PG8_MMA(1, 0, At, B0); PG8_BAR; PG8_SCHED;
            PG8_STAGE(PG8_SB(1, 1), b3 + hstepB, voffB);
            PG8_WAIT_V(6); PG8_BAR; PG8_MMA(1, 1, At, B1); PG8_BAR;
            }
        }
        if constexpr (ALIGN_EPI) { if (wr == 0) PG8_BAR; }
        if constexpr (!Epi::AFTER_DRAIN) { E(acc, cur, wr, wc, fr, fq); S.done(cur); }
        if (!has_next) break;
#pragma unroll
        for (int a = 0; a < 2; ++a)
#pragma unroll
            for (int b = 0; b < 2; ++b)
#pragma unroll
                for (int m = 0; m < 4; ++m)
#pragma unroll
                    for (int n = 0; n < 2; ++n) acc[a][b][m][n] = (f32x4){0.f, 0.f, 0.f, 0.f};
        cur = nxt; cA = nA; cB = nB; ++ui;
        if constexpr (ALIGN_EPI) { if (wr == 1) PG8_BAR; }
    }
    PG8_WAIT_V(0);
    if constexpr (!ALIGN_EPI) { if (wr == 0) PG8_BAR; }
    PG8_BAR;
    if constexpr (Epi::AFTER_DRAIN) { E.fused(acc, cur, wr, wc, fr, fq, lds, wid, lane); S.done(cur); }
#undef PG8_SA
#undef PG8_SB
#undef PG8_STAGE
#undef PG8_LDA
#undef PG8_LDB
#undef PG8_MMA
#undef PG8_WAIT_V
#undef PG8_WAIT_L
#undef PG8_BAR
#undef PG8_SCHED
}
}

constexpr int NWAVES = 8;
constexpr int NB = 2, L = 8192, D = 1024, DEPTH = 4, NC = 3352, NP = 3584, M = NB * L;
constexpr int C_RQ = 0, C_RK = 256, C_RV = 512, C_RG = 768, C_DQKV = 1024, C_DBETA = 1792, C_DA = 1796, C_DG = 1800,
              C_SU = 2056, C_SG = 2312, C_GQ = 2568, C_GK = 2696, C_GV = 2824, C_GCODE = 3080, C_GG = 3096;
constexpr float EPS = 1e-6f;
constexpr size_t MiB = 1u << 20;
constexpr size_t WS_CTL = 0, CTL_ZERO_BYTES = 1 * MiB;
constexpr size_t WS_TAB = 1 * MiB;
constexpr size_t WS_COEF = 3 * MiB;
constexpr size_t WS_WGLU = 4 * MiB;
constexpr size_t WS_WOUT = 5 * MiB;
constexpr size_t WS_WIN = 7 * MiB;
constexpr size_t WS_HY = 14 * MiB;
constexpr size_t WS_P = 46 * MiB;
constexpr size_t WS_RET_KV = WS_HY;
constexpr size_t WS_GLA_KV = WS_HY + 16 * MiB;
constexpr size_t WS_S5_E = WS_HY + 24 * MiB;
constexpr size_t WS_RET_RP = 158 * MiB;
constexpr size_t WS_GLA_RP = 166 * MiB;
constexpr size_t WS_GLA_DEC = 170 * MiB;
constexpr size_t WS_S5_MAT = 171 * MiB;
constexpr size_t WS_S5_SP = 187 * MiB;
constexpr size_t WS_S5_APOW = 191 * MiB;
constexpr size_t WS_DN_WF = 192 * MiB;
constexpr size_t WS_DN_KGF = 200 * MiB;
constexpr size_t WS_DN_UF = 208 * MiB;
constexpr size_t WS_DN_QN = 216 * MiB;
constexpr size_t WS_DN_KN = 224 * MiB;
constexpr size_t WS_DN_SPF = 232 * MiB;
constexpr size_t WS_DN_VNF = 240 * MiB;
constexpr size_t WS_DN_G = 3 * MiB + 640 * 1024;
constexpr size_t WS_DN_GL = 3 * MiB + 900 * 1024;
constexpr size_t WS_END = 248 * MiB;
constexpr int COEF_STRIDE = 2048 + 32768;
constexpr int CW_BAR = 4096;
constexpr int RING_BYTES = 131072, LDSCTL_OFF = 155648  , MISC_OFF = LDSCTL_OFF + 320, ARGS_OFF = LDSCTL_OFF + 512, LDS_BYTES = 163840;

#define GAS __attribute__((address_space(1)))
#define LAS __attribute__((address_space(3)))
typedef unsigned short bf16;
typedef unsigned v4u __attribute__((ext_vector_type(4)));
typedef float f32x4 __attribute__((ext_vector_type(4)));
typedef float f32x2v __attribute__((ext_vector_type(2)));
typedef GAS unsigned gu32;
#define RLX_AGENT __ATOMIC_RELAXED, __HIP_MEMORY_SCOPE_AGENT
#define LDS_WAIT() asm volatile("s_waitcnt lgkmcnt(0)" ::: "memory")
#define VM_WAIT() asm volatile("s_waitcnt vmcnt(0)" ::: "memory")
__device__ __forceinline__ unsigned f2bf(float f) { unsigned u = __builtin_bit_cast(unsigned, f); return (u + 0x7fffu + ((u >> 16) & 1u)) >> 16; }
__device__ __forceinline__ unsigned pk2(float lo, float hi) { return f2bf(lo) | (f2bf(hi) << 16); }
__device__ __forceinline__ float bf2f(bf16 v) { return __builtin_bit_cast(float, (unsigned)v << 16); }
template <int MASK> __device__ __forceinline__ float swz_xor(float v) {
    return __builtin_bit_cast(float, __builtin_amdgcn_ds_swizzle(__builtin_bit_cast(int, v), (MASK << 10) | 0x1F));
}
__device__ __forceinline__ float xor32_add(float v) {
    unsigned a = __builtin_bit_cast(unsigned, v), b = a;
    asm volatile("s_nop 1\n\tv_permlane32_swap_b32 %0, %1" : "+v"(a), "+v"(b));
    return __builtin_bit_cast(float, a) + __builtin_bit_cast(float, b);
}
__device__ __forceinline__ float low_half_bcast(float v) {
    unsigned a = __builtin_bit_cast(unsigned, v), b = a;
    asm volatile("s_nop 1\n\tv_permlane32_swap_b32 %0, %1" : "+v"(a), "+v"(b));
    return __builtin_bit_cast(float, a);
}
__device__ __forceinline__ float wave_sum(float v) {
    v += swz_xor<1>(v); v += swz_xor<2>(v); v += swz_xor<4>(v); v += swz_xor<8>(v); v += swz_xor<16>(v);
    return xor32_add(v);
}
__device__ __forceinline__ float sigmoidf_(float x) { return 1.f / (1.f + expf(-x)); }
__device__ __forceinline__ float siluf_(float x) { return x * sigmoidf_(x); }
__device__ __forceinline__ float softplusf_(float x) { return fmaxf(x, 0.f) + log1pf(expf(-fabsf(x))); }
__device__ __forceinline__ float geluf_(float x) { return 0.5f * x * (1.f + tanhf(0.7978845608028654f * (x + 0.044715f * x * x * x))); }

#define XB_TMO      128
#define XB_XCNT(j)  (256  + 64 * (j))
#define XB_XSUB(j)  (1280 + 64 * (j))
#define XB_XGEN(j)  (2304 + 64 * (j))
#define XB_TOP      3328
#define XB_TOPGEN   3392
#define XCD_BAR_WORDS 3456
#define XB_SPIN_CAP (1u << 18)

__device__ __forceinline__ unsigned xb_ld(unsigned* p)              { return __hip_atomic_load(p, __ATOMIC_RELAXED, __HIP_MEMORY_SCOPE_AGENT); }
__device__ __forceinline__ unsigned xb_add(unsigned* p, unsigned v) { return __hip_atomic_fetch_add(p, v, __ATOMIC_RELAXED, __HIP_MEMORY_SCOPE_AGENT); }
__device__ __forceinline__ unsigned xb_xcc_id() { return (unsigned)__builtin_amdgcn_s_getreg((3 << 11) | 20) & 0xFu; }
#define XB_SPIN(cond, bar) do { unsigned _sp = 0; while (cond) { __builtin_amdgcn_s_sleep(1); \
    if ((++_sp & 255u) == 0u) { if (xb_ld(&(bar)[XB_TMO])) break; if (_sp > XB_SPIN_CAP) { atomicAdd(&(bar)[XB_TMO], 1u); break; } } } } while (0)

struct XcdBarrier {
    unsigned* bar; unsigned x;
    volatile LAS unsigned* st;
};

__device__ __forceinline__ XcdBarrier xcd_barrier_post(unsigned* bar, volatile LAS unsigned* st) {
    XcdBarrier b; b.bar = bar; b.x = xb_xcc_id(); b.st = st;
    if (threadIdx.x == 0) (void)xb_add(&bar[XB_XCNT(b.x)], 1u);
    return b;
}
__device__ __forceinline__ void xcd_barrier_complete(unsigned* bar, unsigned x, unsigned& nloc, unsigned& nx) {
    const unsigned G = gridDim.x * gridDim.y * gridDim.z;
    unsigned sum, cnt, mine, sp = 0u;
    for (;;) {
        sum = 0u; cnt = 0u; mine = 0u;
#pragma unroll
        for (unsigned j = 0; j < 16; ++j) { const unsigned c = xb_ld(&bar[XB_XCNT(j)]); sum += c; cnt += (c > 0u) ? 1u : 0u; mine = (j == x) ? c : mine; }
        if (sum == G) break;
        __builtin_amdgcn_s_sleep(1);
        if ((++sp & 255u) == 0u) { if (xb_ld(&bar[XB_TMO])) break; if (sp > XB_SPIN_CAP) { atomicAdd(&bar[XB_TMO], 1u); break; } }
    }
    nloc = mine > 0u ? mine : 1u; nx = cnt > 0u ? cnt : 1u;
}

__device__ __forceinline__ void xcd_barrier(const XcdBarrier& b) {
    asm volatile("s_waitcnt vmcnt(0)" ::: "memory");
    __syncthreads();
    if (threadIdx.x == 0) {
        unsigned* bar = b.bar; unsigned bx_ = b.x; volatile LAS unsigned* st_ = b.st; asm volatile("" : "+s"(bx_)); asm volatile("" : "+s"(bar)); asm volatile("" : "+s"(st_));
        __builtin_amdgcn_s_waitcnt(0);
        unsigned nloc = st_[0], nx = st_[1];
        if (nloc == 0u) { xcd_barrier_complete(bar, bx_, nloc, nx); st_[0] = nloc; st_[1] = nx; }
        const unsigned old = xb_add(&bar[XB_XSUB(bx_)], 1u);
        const unsigned gen = old / nloc;
        if (old + 1u == (gen + 1u) * nloc) {
            __builtin_amdgcn_fence(__ATOMIC_RELEASE, "agent");
            asm volatile("s_waitcnt vmcnt(0)" ::: "memory");
            const unsigned og = xb_add(&bar[XB_TOP], 1u);
            const unsigned tg = og / nx;
            if (og + 1u == (tg + 1u) * nx) xb_add(&bar[XB_TOPGEN], 1u);
            else XB_SPIN(xb_ld(&bar[XB_TOPGEN]) == tg, bar);
            __builtin_amdgcn_fence(__ATOMIC_ACQUIRE, "agent");
            xb_add(&bar[XB_XGEN(bx_)], 1u);
            asm volatile("s_waitcnt vmcnt(0)" ::: "memory");
        } else {
            XB_SPIN(xb_ld(&bar[XB_XGEN(bx_)]) == gen, bar);
            __builtin_amdgcn_fence(__ATOMIC_ACQUIRE, "agent");
            asm volatile("s_waitcnt vmcnt(0)" ::: "memory");
        }
    }
    __syncthreads();
}

namespace mx {
typedef short bf16x8 __attribute__((ext_vector_type(8)));
typedef short s16x4 __attribute__((ext_vector_type(4)));
typedef float f32x16 __attribute__((ext_vector_type(16)));
constexpr int IROW = 144, IMG_BYTES = 64 * IROW, WLDS = 2 * IMG_BYTES + 1024;
__device__ __forceinline__ int crow(int reg, int h) { return (reg & 3) + 8 * (reg >> 2) + 4 * h; }
__device__ __forceinline__ bf16x8 frag_row(const LAS unsigned char* img, int r0, int c0, int lane) {
    return *(const LAS bf16x8*)(img + (r0 + (lane & 31)) * IROW + (c0 + 8 * (lane >> 5)) * 2);
}
__device__ __forceinline__ bf16x8 frag_tr(const LAS unsigned char* img, int r0, int c0, int lane) {
    const int g = lane >> 4, i = lane & 15, q = i >> 2, p = i & 3;
    LAS unsigned char* a = (LAS unsigned char*)img + (r0 + 8 * (g >> 1) + q) * IROW + (c0 + 16 * (g & 1) + 4 * p) * 2;
    const s16x4 lo = __builtin_amdgcn_ds_read_tr16_b64_v4i16((LAS s16x4*)a);
    const s16x4 hi = __builtin_amdgcn_ds_read_tr16_b64_v4i16((LAS s16x4*)(a + 4 * IROW));
    return (bf16x8){lo[0], lo[1], lo[2], lo[3], hi[0], hi[1], hi[2], hi[3]};
}
__device__ __forceinline__ bf16x8 frag_row_perm(const LAS unsigned char* img, int r0, int c0, int lane) {
    const LAS unsigned char* a = img + (r0 + (lane & 31)) * IROW + (c0 + 4 * (lane >> 5)) * 2;
    const s16x4 lo = *(const LAS s16x4*)a, hi = *(const LAS s16x4*)(a + 16);
    return (bf16x8){lo[0], lo[1], lo[2], lo[3], hi[0], hi[1], hi[2], hi[3]};
}
__device__ __forceinline__ f32x16 mfma(bf16x8 a, bf16x8 b, f32x16 c) { return __builtin_amdgcn_mfma_f32_32x32x16_bf16(a, b, c, 0, 0, 0); }
__device__ __forceinline__ f32x16 zero16() { f32x16 z; for (int i = 0; i < 16; ++i) z[i] = 0.f; return z; }
__device__ __forceinline__ void unpack8(v4u w, float (&f)[8]) {
    f[0] = __builtin_bit_cast(float, w.x << 16); f[1] = __builtin_bit_cast(float, w.x & 0xffff0000u); f[2] = __builtin_bit_cast(float, w.y << 16); f[3] = __builtin_bit_cast(float, w.y & 0xffff0000u);
    f[4] = __builtin_bit_cast(float, w.z << 16); f[5] = __builtin_bit_cast(float, w.z & 0xffff0000u); f[6] = __builtin_bit_cast(float, w.w << 16); f[7] = __builtin_bit_cast(float, w.w & 0xffff0000u);
}
__device__ __forceinline__ v4u pack8(const float (&f)[8]) { v4u w; w.x = pk2(f[0], f[1]); w.y = pk2(f[2], f[3]); w.z = pk2(f[4], f[5]); w.w = pk2(f[6], f[7]); return w; }
template <int NCOL> __device__ __forceinline__ void img_load(LAS unsigned char* img, const bf16* g, int ld, int lane) {
    constexpr int CPR = NCOL / 8;
#pragma unroll
    for (int it = 0; it < CPR; ++it) { int c_ = lane + 64 * it; asm volatile("" : "+v"(c_)); const int c = c_, row = c / CPR, cc = c % CPR;
        *(LAS v4u*)(img + row * IROW + cc * 16) = *(const GAS v4u*)(g + (size_t)row * ld + cc * 8); }
}
template <int DK, class RS> __device__ __forceinline__ void la_kv(const LAS unsigned char* imgK, const LAS unsigned char* imgV, float* KV, const RS& rs, int lane) {
#pragma unroll
    for (int md = 0; md < DK / 32; ++md)
#pragma unroll
        for (int et = 0; et < 2; ++et) {
            f32x16 acc = zero16();
#pragma unroll
            for (int s = 0; s < 4; ++s) acc = mfma(frag_tr(imgK, 16 * s, 32 * md, lane), frag_tr(imgV, 16 * s, 32 * et, lane), acc);
#pragma unroll
            for (int u = 0; u < 2; ++u) { f32x4 o0, o1;
#pragma unroll
                for (int j = 0; j < 4; ++j) { o0[j] = acc[8 * u + j] * rs(32 * md + crow(8 * u + j, lane >> 5)); o1[j] = acc[8 * u + 4 + j] * rs(32 * md + crow(8 * u + 4 + j, lane >> 5)); }
                GAS f32x4* dst = (GAS f32x4*)(KV + ((size_t)((md * 2 + et) * 2 + u) * 64 + lane) * 8); dst[0] = o0; dst[1] = o1; }
        }
}
__device__ __forceinline__ void head_epilogue(const f32x16 (&o)[2][2], const bf16* Gp, int ldp, const float* norm_g, bf16* Yp, int ldy, int lane) {
#pragma unroll
    for (int it = 0; it < 2; ++it) {
        float ss = 0.f;
#pragma unroll
        for (int et = 0; et < 2; ++et)
#pragma unroll
            for (int r = 0; r < 16; ++r) ss += o[et][it][r] * o[et][it][r];
        ss = xor32_add(ss);
        const float rstd = rsqrtf(ss * (1.f / 64.f) + EPS);
        const int i = 32 * it + (lane & 31);
#pragma unroll
        for (int et = 0; et < 2; ++et)
#pragma unroll
            for (int g4 = 0; g4 < 4; ++g4) { const int e0 = 32 * et + 8 * g4 + 4 * (lane >> 5); int i_ = i; asm volatile("" : "+v"(i_));
                const unsigned long long gw = *(const GAS unsigned long long*)(Gp + (size_t)i_ * ldp + e0);
                const f32x4 gn = *(const GAS f32x4*)(norm_g + e0);
                float gt[4] = {__builtin_bit_cast(float, (unsigned)gw << 16), __builtin_bit_cast(float, (unsigned)gw & 0xffff0000u),
                               __builtin_bit_cast(float, (unsigned)(gw >> 32) << 16), __builtin_bit_cast(float, (unsigned)(gw >> 32) & 0xffff0000u)};
                float ov[4];
#pragma unroll
                for (int j = 0; j < 4; ++j) ov[j] = o[et][it][4 * g4 + j] * rstd * gn[j] * (gt[j] / (1.f + __expf(-gt[j])));
                *(GAS unsigned long long*)(Yp + (size_t)i_ * ldy + e0) = (unsigned long long)pk2(ov[0], ov[1]) | ((unsigned long long)pk2(ov[2], ov[3]) << 32); }
    }
}
template <int DK> __device__ __forceinline__ void la_out(LAS unsigned char* wl, const bf16* Qp, const bf16* Kp, int ldq, const bf16* Vp, const bf16* Gp, int ldp,
                                                         const bf16* RP, const float* norm_g, bf16* Yp, int ldy, int lane) {
    LAS unsigned char* img0 = wl; LAS unsigned char* img1 = wl + IMG_BYTES;
    img_load<DK>(img0, Qp, ldq, lane); img_load<DK>(img1, Kp, ldq, lane);
    f32x16 sc[3];
#pragma unroll
    for (int t = 0; t < 3; ++t) { const int mt = (t == 1) ? 0 : 1, nt = (t == 0) ? 0 : (t == 1 ? 0 : 1); sc[t] = zero16();
#pragma unroll
        for (int s = 0; s < DK / 16; ++s) sc[t] = mfma(frag_row(img0, 32 * mt, 16 * s, lane), frag_row(img1, 32 * nt, 16 * s, lane), sc[t]); }
    f32x16 o[2][2];
#pragma unroll
    for (int et = 0; et < 2; ++et)
#pragma unroll
        for (int it = 0; it < 2; ++it) { o[et][it] = zero16();
#pragma unroll
            for (int md = 0; md < DK / 32; ++md)
#pragma unroll
                for (int u = 0; u < 2; ++u) { const bf16x8 a = *(const GAS bf16x8*)(RP + ((size_t)((md * 2 + et) * 2 + u) * 64 + lane) * 8);
                    o[et][it] = mfma(a, frag_row_perm(img0, 32 * it, 32 * md + 16 * u, lane), o[et][it]); } }
#pragma unroll
    for (int t = 0; t < 3; ++t) { const int mt = (t == 1) ? 0 : 1, nt = (t == 0) ? 0 : (t == 1 ? 0 : 1);
#pragma unroll
        for (int r = 0; r < 16; ++r) { const int i = 32 * mt + crow(r, lane >> 5), j = 32 * nt + (lane & 31);
            *(LAS bf16*)(img0 + i * IROW + j * 2) = (bf16)f2bf(j <= i ? sc[t][r] : 0.f); } }
#pragma unroll
    for (int r = 0; r < 16; ++r) { const int i = crow(r, lane >> 5), j = 32 + (lane & 31); *(LAS bf16*)(img0 + i * IROW + j * 2) = 0; }
    img_load<64>(img1, Vp, ldp, lane);
#pragma unroll
    for (int et = 0; et < 2; ++et)
#pragma unroll
        for (int it = 0; it < 2; ++it)
#pragma unroll
            for (int s = 0; s < 4; ++s) { if (it == 0 && s >= 2) continue;
                o[et][it] = mfma(frag_tr(img1, 16 * s, 32 * et, lane), frag_row(img0, 32 * it, 16 * s, lane), o[et][it]); }
    head_epilogue(o, Gp, ldp, norm_g, Yp, ldy, lane);
}
}

__device__ __forceinline__ void ret_A(LAS unsigned char* wl, bf16* Pt  , const f32x2v* tab, int pos0, int h, float* KV, int lane) {
    LAS unsigned char* img0 = wl; LAS unsigned char* img1 = wl + mx::IMG_BYTES;
    const float lg = log2f(1.f - exp2f(-5.f - (float)h));
    const int cc = lane & 7;
#pragma unroll
    for (int it = 0; it < 8; ++it) { int row_ = (lane >> 3) + 8 * it; asm volatile("" : "+v"(row_)); const int row = row_;
        bf16* qp = Pt + (size_t)row * NP + C_RQ + h * 64 + cc * 8; bf16* kp = Pt + (size_t)row * NP + C_RK + h * 64 + cc * 8;
        float q[8], k[8]; mx::unpack8(*(const GAS v4u*)qp, q); mx::unpack8(*(const GAS v4u*)kp, k);
        const GAS f32x4* tp = (const GAS f32x4*)(tab + (size_t)(pos0 + row) * 32 + cc * 4); const f32x4 t0 = tp[0], t1 = tp[1];
        const float cs[4] = {t0[0], t0[2], t1[0], t1[2]}, sn[4] = {t0[1], t0[3], t1[1], t1[3]};
        const float dq = 0.125f * exp2f((float)(row + 1) * lg), dk = exp2f(-(float)(row + 1) * lg);
        float qo[8], ko[8];
#pragma unroll
        for (int pz = 0; pz < 4; ++pz) { qo[2 * pz] = (q[2 * pz] * cs[pz] - q[2 * pz + 1] * sn[pz]) * dq; qo[2 * pz + 1] = (q[2 * pz] * sn[pz] + q[2 * pz + 1] * cs[pz]) * dq;
            ko[2 * pz] = (k[2 * pz] * cs[pz] - k[2 * pz + 1] * sn[pz]) * dk; ko[2 * pz + 1] = (k[2 * pz] * sn[pz] + k[2 * pz + 1] * cs[pz]) * dk; }
        const v4u kw = mx::pack8(ko);
        *(GAS v4u*)qp = mx::pack8(qo); *(GAS v4u*)kp = kw;
        *(LAS v4u*)(img0 + row * mx::IROW + cc * 16) = kw; }
    mx::img_load<64>(img1, Pt + C_RV + h * 64, NP, lane);
    const float g64 = exp2f(64.f * lg);
    mx::la_kv<64>(img0, img1, KV, [g64](int) { return g64; }, lane);
}
__device__ __forceinline__ void gla_A(LAS unsigned char* wl, bf16* Pt, const float* w_gk  , const float* b_gk, int h, float* KV, float* DEC, int lane) {
    LAS unsigned char* img0 = wl; LAS unsigned char* img1 = wl + mx::IMG_BYTES; LAS float* vec = (LAS float*)(wl + 2 * mx::IMG_BYTES);
    LAS float* cumL = (LAS float*)img1;
    const int hh = lane >> 5, d = lane & 31;
    float wg[16];
#pragma unroll
    for (int r = 0; r < 16; ++r) wg[r] = w_gk[r * 128 + h * 32 + d];
    const float bg = b_gk[h * 32 + d];
    float cum = 0.f;
    { const bf16* pr = Pt + (size_t)(32 * hh) * NP + C_GCODE;
#pragma unroll 4
      for (int jj = 0; jj < 32; ++jj, pr += NP) {
        float a[8], b[8]; mx::unpack8(*(const GAS v4u*)pr, a); mx::unpack8(*(const GAS v4u*)(pr + 8), b);
        float z = bg;
#pragma unroll
        for (int r = 0; r < 8; ++r) z += a[r] * wg[r] + b[r] * wg[8 + r];
        cum += -softplusf_(-z) * (1.f / 16.f); cumL[(32 * hh + jj) * 32 + d] = cum; } }
    const float first_tot = low_half_bcast(cum);
    const float add = hh ? first_tot : 0.f;
    if (hh) vec[d] = expf(cum + first_tot);
    const float qs = 0.17677669529663687f;
    { GAS bf16* qp = (GAS bf16*)(Pt + (size_t)(32 * hh) * NP + C_GQ + h * 32 + d); GAS bf16* kp = (GAS bf16*)(Pt + (size_t)(32 * hh) * NP + C_GK + h * 32 + d);
#pragma unroll 4
      for (int jj = 0; jj < 32; ++jj, qp += NP, kp += NP) { const int row = 32 * hh + jj;
        const float e = expf(cumL[row * 32 + d] + add);
        const bf16 qv = (bf16)f2bf(bf2f(*qp) * qs * e), kv = (bf16)f2bf(bf2f(*kp) / e);
        *qp = qv; *kp = kv; *(LAS bf16*)(img0 + row * mx::IROW + d * 2) = kv; } }
    LDS_WAIT();
    mx::img_load<64>(img1, Pt + C_GV + h * 64, NP, lane);
    if (lane < 32) DEC[lane] = vec[lane];
    mx::la_kv<32>(img0, img1, KV, [vec](int dd) { return vec[dd]; }, lane);
}
template <int NMD> __device__ __forceinline__ void la_scan(const float* KV, bf16* RP, const float* DEC, float g64, int sub  , int lane) {
    constexpr int CH = NMD * 4 * 64 * 8;
    const int u = sub & 1, h = lane >> 5;
    float st[8];
#pragma unroll
    for (int j = 0; j < 8; ++j) st[j] = 0.f;
    const float* kp = KV + ((size_t)sub * 64 + lane) * 8; bf16* rp = RP + ((size_t)sub * 64 + lane) * 8;
    for (int n0 = 0; n0 < 128; n0 += 8) {
        f32x4 a[8][2], dc[8][2];
#pragma unroll
        for (int n = 0; n < 8; ++n) { const GAS f32x4* src = (const GAS f32x4*)(kp + (size_t)(n0 + n) * CH); a[n][0] = src[0]; a[n][1] = src[1];
            if (DEC) { const float* dp = DEC + (size_t)(n0 + n) * 32 + 16 * u + 4 * h; dc[n][0] = *(const GAS f32x4*)dp; dc[n][1] = *(const GAS f32x4*)(dp + 8); }
            else { dc[n][0] = (f32x4){g64, g64, g64, g64}; dc[n][1] = dc[n][0]; } }
#pragma unroll
        for (int n = 0; n < 8; ++n) {
            *(GAS v4u*)(rp + (size_t)(n0 + n) * CH) = mx::pack8(st);
#pragma unroll
            for (int j = 0; j < 4; ++j) { st[j] = st[j] * dc[n][0][j] + a[n][0][j]; st[4 + j] = st[4 + j] * dc[n][1][j] + a[n][1][j]; }
        }
    }
}

constexpr size_t S5_MAT_LAYER = 4 * MiB, S5_EM_OFF = 0, S5_KM_OFF = 1 * MiB, S5_CM_OFF = 3 * MiB;
template <bool OUT> __device__ __forceinline__ void s5_item(bf16* Pm  , const unsigned char* mats  , float* E, const bf16* SP, int g, int mu, int lane) {
    using namespace mx;
    const int m = lane & 31, hf = lane >> 5;
    bf16x8 A[16];
    { const bf16* ap = Pm + (size_t)((mu * 32 + m) * 16) * NP + g * 16 + 8 * hf;
#pragma unroll
      for (int j = 0; j < 16; ++j) A[j] = *(const GAS bf16x8*)(ap + (size_t)j * NP); }
    if constexpr (!OUT) {
        const bf16* em = (const bf16*)(mats + S5_EM_OFF) + (size_t)g * 128 * 256;
#pragma unroll 1
        for (int nt = 0; nt < 4; ++nt) {
            f32x16 acc = zero16();
            const bf16* bp = em + (size_t)(32 * nt + m) * 256 + 8 * hf;
#pragma unroll
            for (int s = 0; s < 16; ++s) acc = mfma(A[s], *(const GAS bf16x8*)(bp + 16 * s), acc);
            float* ep = E + (size_t)(mu * 32) * 2048 + g * 128 + 32 * nt + m;
#pragma unroll
            for (int r = 0; r < 16; ++r) ((GAS float*)ep)[(size_t)crow(r, hf) * 2048] = acc[r];
        }
    } else {
        bf16x8 A2[8];
        { const bf16* sp = SP + (size_t)(mu * 32 + m) * 2048 + g * 128 + 8 * hf;
#pragma unroll
          for (int s = 0; s < 8; ++s) A2[s] = *(const GAS bf16x8*)(sp + 16 * s); }
        const bf16* km = (const bf16*)(mats + S5_KM_OFF) + (size_t)g * 256 * 256;
        const bf16* cm = (const bf16*)(mats + S5_CM_OFF) + (size_t)g * 256 * 128;
#pragma unroll 1
        for (int nt = 0; nt < 8; ++nt) {
            f32x16 acc = zero16();
            const bf16* bp = km + (size_t)(32 * nt + m) * 256 + 8 * hf;
            const bf16* cp = cm + (size_t)(32 * nt + m) * 128 + 8 * hf;
#pragma unroll
            for (int s = 0; s < 16; ++s) acc = mfma(A[s], *(const GAS bf16x8*)(bp + 16 * s), acc);
#pragma unroll
            for (int s = 0; s < 8; ++s) acc = mfma(A2[s], *(const GAS bf16x8*)(cp + 16 * s), acc);
            bf16* yp = Pm + (size_t)((mu * 32) * 16 + 2 * nt + (m >> 4)) * NP + g * 16 + (m & 15);
#pragma unroll
            for (int r = 0; r < 16; ++r) ((GAS bf16*)yp)[(size_t)(crow(r, hf) * 16) * NP] = (bf16)f2bf(geluf_(acc[r]));
        }
    }
}
__device__ __forceinline__ void s5_scan_block(LAS float* sh  , const float* E  , bf16* SP, const float* a16p  , int g, int tid) {
    const int p = tid & 63, seg = tid >> 6;
    const float ar = a16p[2 * p], ai = a16p[2 * p + 1];
    const float* er = E + (size_t)(seg * 64) * 2048 + g * 128 + p;
    float sr = 0.f, si = 0.f;
    for (int n0 = 0; n0 < 64; n0 += 8) { float xr[8], xi[8];
#pragma unroll
        for (int n = 0; n < 8; ++n) { xr[n] = ((const GAS float*)er)[(size_t)(n0 + n) * 2048]; xi[n] = ((const GAS float*)er)[(size_t)(n0 + n) * 2048 + 64]; }
#pragma unroll
        for (int n = 0; n < 8; ++n) { const float nr = ar * sr - ai * si + xr[n], ni = ar * si + ai * sr + xi[n]; sr = nr; si = ni; } }
    sh[(seg * 64 + p) * 2] = sr; sh[(seg * 64 + p) * 2 + 1] = si;
    float br = ar, bi = ai;
#pragma unroll
    for (int k = 0; k < 6; ++k) { const float nr = br * br - bi * bi, ni = 2.f * br * bi; br = nr; bi = ni; }
    __syncthreads();
    sr = 0.f; si = 0.f;
    for (int s2 = 0; s2 < seg; ++s2) { const float lr = sh[(s2 * 64 + p) * 2], li = sh[(s2 * 64 + p) * 2 + 1]; const float nr = br * sr - bi * si + lr, ni = br * si + bi * sr + li; sr = nr; si = ni; }
    bf16* sp = SP + (size_t)(seg * 64) * 2048 + g * 128 + p;
    for (int n0 = 0; n0 < 64; n0 += 8) { float xr[8], xi[8];
#pragma unroll
        for (int n = 0; n < 8; ++n) { xr[n] = ((const GAS float*)er)[(size_t)(n0 + n) * 2048]; xi[n] = ((const GAS float*)er)[(size_t)(n0 + n) * 2048 + 64]; }
#pragma unroll
        for (int n = 0; n < 8; ++n) { ((GAS bf16*)sp)[(size_t)(n0 + n) * 2048] = (bf16)f2bf(sr); ((GAS bf16*)sp)[(size_t)(n0 + n) * 2048 + 64] = (bf16)f2bf(si);
            const float nr = ar * sr - ai * si + xr[n], ni = ar * si + ai * sr + xi[n]; sr = nr; si = ni; } }
    __syncthreads();
}

typedef float f32x4m __attribute__((ext_vector_type(4)));
__device__ __forceinline__ f32x4m mfma16(mx::bf16x8 a, mx::bf16x8 b, f32x4m c) { return __builtin_amdgcn_mfma_f32_16x16x32_bf16(a, b, c, 0, 0, 0); }
__device__ __forceinline__ mx::bf16x8 pack_bf8(f32x4m a, f32x4m b) {
    const unsigned w0 = pk2(a[0], a[1]), w1 = pk2(a[2], a[3]), w2 = pk2(b[0], b[1]), w3 = pk2(b[2], b[3]);
    const v4u w = {w0, w1, w2, w3}; return __builtin_bit_cast(mx::bf16x8, w);
}
template <int I, int C8> __device__ __forceinline__ void fs_chunk(const float (&t)[64], const LAS unsigned char* img1, float& a0, float& a1) {
    if constexpr (C8 * 8 < I) {
        float a[8]; mx::unpack8(*(const LAS v4u*)(img1 + I * mx::IROW + C8 * 16), a);
        if constexpr (C8 * 8 + 0 < I) a0 -= a[0] * t[C8 * 8 + 0];
        if constexpr (C8 * 8 + 1 < I) a1 -= a[1] * t[C8 * 8 + 1];
        if constexpr (C8 * 8 + 2 < I) a0 -= a[2] * t[C8 * 8 + 2];
        if constexpr (C8 * 8 + 3 < I) a1 -= a[3] * t[C8 * 8 + 3];
        if constexpr (C8 * 8 + 4 < I) a0 -= a[4] * t[C8 * 8 + 4];
        if constexpr (C8 * 8 + 5 < I) a1 -= a[5] * t[C8 * 8 + 5];
        if constexpr (C8 * 8 + 6 < I) a0 -= a[6] * t[C8 * 8 + 6];
        if constexpr (C8 * 8 + 7 < I) a1 -= a[7] * t[C8 * 8 + 7];
        fs_chunk<I, C8 + 1>(t, img1, a0, a1);
    }
}
template <int I> __device__ __forceinline__ void fs_row(float (&t)[64], const LAS unsigned char* img1, int lane) {
    if constexpr (I < 64) {
        float a0 = -bf2f(*(const LAS bf16*)(img1 + I * mx::IROW + lane * 2)), a1 = 0.f;
        fs_chunk<I, 0>(t, img1, a0, a1);
        t[I] = a0 + a1;
        fs_row<I + 1>(t, img1, lane);
    }
}
template <int I> __device__ __forceinline__ void fs_store(const float (&t)[64], LAS unsigned char* img1, int lane) {
    if constexpr (I < 64) { *(LAS bf16*)(img1 + I * mx::IROW + lane * 2) = (bf16)f2bf(t[I]); fs_store<I + 1>(t, img1, lane); }
}
template <class F> __device__ __forceinline__ void dn_conv_rows(const bf16* Pt, int col0, const float* cw, int wcol0, int n, int lane, F&& f) {
    const int cc = lane & 7;
    f32x4 w[4][2];
#pragma unroll
    for (int j = 0; j < 4; ++j) { w[j][0] = *(const GAS f32x4*)(cw + j * 768 + wcol0 + cc * 8); w[j][1] = *(const GAS f32x4*)(cw + j * 768 + wcol0 + cc * 8 + 4); }
#pragma unroll
    for (int it = 0; it < 8; ++it) { int row_ = (lane >> 3) + 8 * it; asm volatile("" : "+v"(row_)); const int row = row_;
        float x[8];
#pragma unroll
        for (int e = 0; e < 8; ++e) x[e] = 0.f;
#pragma unroll
        for (int j = 0; j < 4; ++j) { const int rr = row - 3 + j;
            if (n > 0 || rr >= 0) { float r[8]; mx::unpack8(*(const GAS v4u*)(Pt + (ptrdiff_t)rr * NP + col0 + cc * 8), r);
#pragma unroll
                for (int e = 0; e < 4; ++e) { x[e] += w[j][0][e] * r[e]; x[4 + e] += w[j][1][e] * r[4 + e]; } } }
#pragma unroll
        for (int e = 0; e < 8; ++e) x[e] = x[e] / (1.f + __expf(-x[e]));
        f(it, row, cc, x); }
}
struct DnBufs { bf16* WF; bf16* KGF; bf16* UF; bf16* QN; bf16* KN; float* G; float* GL; };
__device__ __forceinline__ void dn_A(LAS unsigned char* wl, const bf16* Pt, size_t t0g, int n, int h, int item, const float* cw, float a_log, float dt_bias, const DnBufs& B, int lane_in) {
    using namespace mx;
    int lane_l = lane_in; asm volatile("" : "+v"(lane_l)); const int lane = lane_l;
    LAS unsigned char* img0 = wl; LAS unsigned char* img1 = wl + IMG_BYTES; LAS float* vec = (LAS float*)(wl + 2 * IMG_BYTES);
    LAS float* vb = vec; LAS float* vg = vec + 64; LAS float* ve = vec + 128; LAS float* vs = vec + 192;
    const int hf = lane >> 5;
    {
        const float bin = bf2f(*(const GAS bf16*)(Pt + (size_t)lane * NP + C_DBETA + h)), ain = bf2f(*(const GAS bf16*)(Pt + (size_t)lane * NP + C_DA + h));
        const float beta = 1.f / (1.f + expf(-bin)), gj = -expf(a_log) * softplusf_(ain + dt_bias);
        float gc = gj;
#pragma unroll
        for (int sft = 1; sft < 64; sft <<= 1) { ve[lane] = gc; LDS_WAIT(); const float o = ve[lane >= sft ? lane - sft : 0]; LDS_WAIT(); gc += (lane >= sft) ? o : 0.f; }
        vg[lane] = gc; vb[lane] = beta;
        LDS_WAIT();
        const float glast = vg[63];
        ve[lane] = expf(glast - gc); vs[lane] = beta * expf(gc);
        ((GAS float*)B.G)[(t0g + lane) * 4 + h] = gc;
        if (lane == 0) ((GAS float*)B.GL)[item] = expf(glast);
        LDS_WAIT();
    }
    dn_conv_rows(Pt, C_DQKV + 256 + h * 64, cw, 256 + h * 64, n, lane, [&](int, int row, int cc, float (&x)[8]) {
        float ss = 0.f;
#pragma unroll
        for (int e = 0; e < 8; ++e) ss += x[e] * x[e];
        ss += swz_xor<1>(ss); ss += swz_xor<2>(ss); ss += swz_xor<4>(ss);
        const float rs = rsqrtf(ss + EPS);
#pragma unroll
        for (int e = 0; e < 8; ++e) x[e] *= rs;
        const v4u w = pack8(x);
        *(LAS v4u*)(img0 + row * IROW + cc * 16) = w; *(GAS v4u*)(B.KN + (t0g + row) * 256 + h * 64 + cc * 8) = w; });
    dn_conv_rows(Pt, C_DQKV + h * 64, cw, h * 64, n, lane, [&](int, int row, int cc, float (&x)[8]) {
        float ss = 0.f;
#pragma unroll
        for (int e = 0; e < 8; ++e) ss += x[e] * x[e];
        ss += swz_xor<1>(ss); ss += swz_xor<2>(ss); ss += swz_xor<4>(ss);
        const float rs = rsqrtf(ss + EPS) * 0.125f;
#pragma unroll
        for (int e = 0; e < 8; ++e) x[e] *= rs;
        *(GAS v4u*)(B.QN + (t0g + row) * 256 + h * 64 + cc * 8) = pack8(x); });
    LDS_WAIT();
#pragma unroll
    for (int t = 0; t < 3; ++t) { const int mt = (t == 1) ? 0 : 1, nt = (t == 2) ? 1 : 0;
        f32x16 acc = zero16();
#pragma unroll
        for (int s = 0; s < 4; ++s) acc = mfma(frag_row(img0, 32 * mt, 16 * s, lane), frag_row(img0, 32 * nt, 16 * s, lane), acc);
        const int j = 32 * nt + (lane & 31); const float gj = vg[j];
#pragma unroll
        for (int g4 = 0; g4 < 4; ++g4) { const int i0 = 32 * mt + 8 * g4 + 4 * hf; const f32x4 b4 = *(const LAS f32x4*)(vb + i0), g4v = *(const LAS f32x4*)(vg + i0);
#pragma unroll
            for (int e = 0; e < 4; ++e) { const int i = i0 + e; const float a = b4[e] * acc[4 * g4 + e] * __expf(fminf(g4v[e] - gj, 0.f));
                *(LAS bf16*)(img1 + i * IROW + j * 2) = (bf16)f2bf(j < i ? a : 0.f); } } }
#pragma unroll
    for (int r = 0; r < 16; ++r) { const int i = crow(r, hf), j = 32 + (lane & 31); *(LAS bf16*)(img1 + i * IROW + j * 2) = 0; }
    LDS_WAIT();
    {
        float t[64];
        fs_row<0>(t, img1, lane);
        LDS_WAIT();
        fs_store<0>(t, img1, lane);
        LDS_WAIT();
        *(LAS bf16*)(img1 + lane * mx::IROW + lane * 2) = (bf16)0x3f80;
    }
    {
        const int kg = lane >> 4, i16 = lane & 15, q = i16 >> 2, p = i16 & 3;
#pragma unroll
        for (int t = 0; t < 4; ++t)
#pragma unroll
            for (int s = 0; s < 2; ++s) { float o[8];
#pragma unroll
                for (int m = 0; m < 2; ++m) { const int c0 = 32 * s + 16 * m + 4 * kg;
                    const s16x4 x = __builtin_amdgcn_ds_read_tr16_b64_v4i16((LAS s16x4*)(img0 + (c0 + q) * IROW + (16 * t + 4 * p) * 2));
                    const f32x4 f = *(const LAS f32x4*)(ve + c0);
#pragma unroll
                    for (int e = 0; e < 4; ++e) o[4 * m + e] = bf2f((bf16)x[e]) * f[e]; }
                *(GAS v4u*)(B.KGF + ((size_t)((item * 4 + t) * 2 + s) * 64 + lane) * 8) = pack8(o); }
    }
#pragma unroll
    for (int it = 0; it < 8; ++it) { int c_ = lane + 64 * it; asm volatile("" : "+v"(c_)); const int row = c_ >> 3, cc = c_ & 7;
        float x[8]; unpack8(*(const LAS v4u*)(img0 + row * IROW + cc * 16), x); const float sc = vs[row];
#pragma unroll
        for (int e = 0; e < 8; ++e) x[e] *= sc;
        *(LAS v4u*)(img0 + row * IROW + cc * 16) = pack8(x); }
    LDS_WAIT();
    {
        f32x16 w[2][2];
#pragma unroll
        for (int mt = 0; mt < 2; ++mt)
#pragma unroll
            for (int nt = 0; nt < 2; ++nt) { w[mt][nt] = zero16();
#pragma unroll
                for (int s = 0; s < 4; ++s) { if (mt == 0 && s >= 2) continue; w[mt][nt] = mfma(frag_row(img1, 32 * mt, 16 * s, lane), frag_tr(img0, 16 * s, 32 * nt, lane), w[mt][nt]); } }
#pragma unroll
        for (int mt = 0; mt < 2; ++mt)
#pragma unroll
            for (int nt = 0; nt < 2; ++nt)
#pragma unroll
                for (int r = 0; r < 16; ++r) *(LAS bf16*)(img0 + (32 * mt + crow(r, hf)) * IROW + (32 * nt + (lane & 31)) * 2) = (bf16)f2bf(w[mt][nt][r]);
        LDS_WAIT();
        const int kg = lane >> 4;
#pragma unroll
        for (int tc = 0; tc < 4; ++tc)
#pragma unroll
            for (int s = 0; s < 2; ++s) { const LAS unsigned char* a = img0 + (16 * tc + (lane & 15)) * IROW + (32 * s + 4 * kg) * 2;
                const s16x4 lo = *(const LAS s16x4*)a, hi = *(const LAS s16x4*)(a + 32);
                const bf16x8 v = {lo[0], lo[1], lo[2], lo[3], hi[0], hi[1], hi[2], hi[3]};
                *(GAS bf16x8*)(B.WF + ((size_t)((item * 4 + tc) * 2 + s) * 64 + lane) * 8) = v; }
        LDS_WAIT();
    }
    dn_conv_rows(Pt, C_DQKV + 512 + h * 64, cw, 512 + h * 64, n, lane, [&](int, int row, int cc, float (&x)[8]) {
        const float bt = vb[row];
#pragma unroll
        for (int e = 0; e < 8; ++e) x[e] *= bt;
        *(LAS v4u*)(img0 + row * IROW + cc * 16) = pack8(x); });
    LDS_WAIT();
#pragma unroll
    for (int mt = 0; mt < 2; ++mt)
#pragma unroll
        for (int nt = 0; nt < 2; ++nt) { f32x16 u = zero16();
#pragma unroll
            for (int s = 0; s < 4; ++s) { if (mt == 0 && s >= 2) continue; u = mfma(frag_row(img1, 32 * mt, 16 * s, lane), frag_tr(img0, 16 * s, 32 * nt, lane), u); }
            const int el = lane & 31;
#pragma unroll
            for (int g4 = 0; g4 < 4; ++g4) { const int tc = 2 * mt + (g4 >> 1), q_ = 2 * (g4 & 1) + hf, slc = 2 * nt + (el >> 4), lp = (el & 15) + 16 * q_;
                *(GAS unsigned long long*)(B.UF + ((size_t)((item * 4 + slc) * 4 + tc) * 64 + lp) * 4) = (unsigned long long)pk2(u[4 * g4], u[4 * g4 + 1]) | ((unsigned long long)pk2(u[4 * g4 + 2], u[4 * g4 + 3]) << 32); } }
    LDS_WAIT();
}
__device__ __forceinline__ void dn_scan(const bf16* WF, const bf16* KGF, const bf16* UF, const float* GL, bf16* SPF, bf16* VNF, int bh, int slc, int lane) {
    using mx::bf16x8;
    f32x4m S[4];
#pragma unroll
    for (int t = 0; t < 4; ++t) S[t] = (f32x4m){0.f, 0.f, 0.f, 0.f};
    const int e16 = lane & 15, q_ = lane >> 4, lp = 16 * (slc & 1) + e16 + 32 * (q_ & 1), et = slc >> 1;
    bf16x8 W[4][2], KG[4][2]; unsigned long long U[4]; float gl;
    { const int item = bh * 128;
#pragma unroll
      for (int t = 0; t < 4; ++t) {
#pragma unroll
        for (int s = 0; s < 2; ++s) { W[t][s] = *(const GAS bf16x8*)(WF + ((size_t)((item * 4 + t) * 2 + s) * 64 + lane) * 8); KG[t][s] = *(const GAS bf16x8*)(KGF + ((size_t)((item * 4 + t) * 2 + s) * 64 + lane) * 8); }
        U[t] = *(const GAS unsigned long long*)(UF + ((size_t)((item * 4 + slc) * 4 + t) * 64 + lane) * 4); }
      gl = ((const GAS float*)GL)[item]; }
#pragma unroll 1
    for (int n = 0; n < 128; ++n) {
        const int item = bh * 128 + n, nx = bh * 128 + (n + 1 < 128 ? n + 1 : n);
        bf16x8 nW[4][2], nKG[4][2]; unsigned long long nU[4];
#pragma unroll
        for (int t = 0; t < 4; ++t) {
#pragma unroll
            for (int s = 0; s < 2; ++s) { nW[t][s] = *(const GAS bf16x8*)(WF + ((size_t)((nx * 4 + t) * 2 + s) * 64 + lane) * 8); nKG[t][s] = *(const GAS bf16x8*)(KGF + ((size_t)((nx * 4 + t) * 2 + s) * 64 + lane) * 8); }
            nU[t] = *(const GAS unsigned long long*)(UF + ((size_t)((nx * 4 + slc) * 4 + t) * 64 + lane) * 4); }
        const float ngl = ((const GAS float*)GL)[nx];
        const bf16x8 Sb0 = pack_bf8(S[0], S[1]), Sb1 = pack_bf8(S[2], S[3]);
        f32x4m vn[4];
#pragma unroll
        for (int t = 0; t < 4; ++t) { f32x4m acc = {0.f, 0.f, 0.f, 0.f}; acc = mfma16(W[t][0], Sb0, acc); acc = mfma16(W[t][1], Sb1, acc);
            const unsigned lo = (unsigned)U[t], hi = (unsigned)(U[t] >> 32);
            vn[t][0] = __builtin_bit_cast(float, lo << 16) - acc[0]; vn[t][1] = __builtin_bit_cast(float, lo & 0xffff0000u) - acc[1];
            vn[t][2] = __builtin_bit_cast(float, hi << 16) - acc[2]; vn[t][3] = __builtin_bit_cast(float, hi & 0xffff0000u) - acc[3]; }
        const bf16x8 vb0 = pack_bf8(vn[0], vn[1]), vb1 = pack_bf8(vn[2], vn[3]);
        { const size_t b0 = ((size_t)((item * 2 + et) * 4 + (q_ >> 1)) * 64 + lp) * 8, b1 = ((size_t)((item * 2 + et) * 4 + 2 + (q_ >> 1)) * 64 + lp) * 8;
          *(GAS bf16x8*)(SPF + b0) = Sb0; *(GAS bf16x8*)(SPF + b1) = Sb1; *(GAS bf16x8*)(VNF + b0) = vb0; *(GAS bf16x8*)(VNF + b1) = vb1; }
#pragma unroll
        for (int t = 0; t < 4; ++t) { f32x4m acc = S[t] * gl; acc = mfma16(KG[t][0], vb0, acc); acc = mfma16(KG[t][1], vb1, acc); S[t] = acc; }
#pragma unroll
        for (int t = 0; t < 4; ++t) { W[t][0] = nW[t][0]; W[t][1] = nW[t][1]; KG[t][0] = nKG[t][0]; KG[t][1] = nKG[t][1]; U[t] = nU[t]; }
        gl = ngl;
    }
}
constexpr int DNS_SLOT = 24576, DNS_RING = 6;
__device__ __forceinline__ void dn_scan_block(LAS unsigned char* ring, const bf16* WF, const bf16* KGF, const bf16* UF, const float* GL, bf16* SPF, bf16* VNF, int bh, int wave, int lane) {
    using mx::bf16x8;
    if (wave >= 4) {
        const int lw = wave - 4;
        auto issue = [&](int n) { const int nn = n < 128 ? n : 127; const size_t item = (size_t)bh * 128 + nn; LAS unsigned char* slot = ring + (n % DNS_RING) * DNS_SLOT;
#pragma unroll
            for (int i = 0; i < 6; ++i) { const int p = 6 * lw + i;
                const bf16* src = p < 8 ? WF + (item * 8 + p) * 512 : (p < 16 ? KGF + (item * 8 + (p - 8)) * 512 : UF + item * 4096 + (size_t)(p - 16) * 512);
                __builtin_amdgcn_global_load_lds((const GAS unsigned*)(src + lane * 8), (LAS unsigned*)(slot + p * 1024), 16, 0, 0); } };
        for (int k = 0; k < 5; ++k) issue(k);
        asm volatile("s_waitcnt vmcnt(24)" ::: "memory"); __builtin_amdgcn_s_barrier();
#pragma unroll 1
        for (int n = 0; n < 128; ++n) { issue(n + 5); asm volatile("s_waitcnt vmcnt(24)" ::: "memory"); __builtin_amdgcn_s_barrier(); }
        asm volatile("s_waitcnt vmcnt(0)" ::: "memory");
        return;
    }
    const int slc = wave;
    f32x4m S[4];
#pragma unroll
    for (int t = 0; t < 4; ++t) S[t] = (f32x4m){0.f, 0.f, 0.f, 0.f};
    const int e16 = lane & 15, q_ = lane >> 4, lp = 16 * (slc & 1) + e16 + 32 * (q_ & 1), et = slc >> 1;
    const float glv0 = ((const GAS float*)GL)[bh * 128 + lane], glv1 = ((const GAS float*)GL)[bh * 128 + 64 + lane];
    asm volatile("" ::: "memory"); __builtin_amdgcn_s_barrier(); asm volatile("" ::: "memory");
#pragma unroll 1
    for (int n = 0; n < 128; ++n) {
        const int item = bh * 128 + n;
        const LAS unsigned char* slot = ring + (n % DNS_RING) * DNS_SLOT;
        const float gl = __builtin_bit_cast(float, __builtin_amdgcn_readlane(__builtin_bit_cast(int, n < 64 ? glv0 : glv1), n & 63));
        bf16x8 W[4][2], KG[4][2]; unsigned long long U[4];
#pragma unroll
        for (int t = 0; t < 4; ++t) {
#pragma unroll
            for (int s = 0; s < 2; ++s) { W[t][s] = *(const LAS bf16x8*)(slot + (t * 2 + s) * 1024 + lane * 16); KG[t][s] = *(const LAS bf16x8*)(slot + 8192 + (t * 2 + s) * 1024 + lane * 16); }
            U[t] = *(const LAS unsigned long long*)(slot + 16384 + ((slc * 4 + t) * 64 + lane) * 8); }
        const bf16x8 Sb0 = pack_bf8(S[0], S[1]), Sb1 = pack_bf8(S[2], S[3]);
        f32x4m vn[4];
#pragma unroll
        for (int t = 0; t < 4; ++t) { f32x4m acc = {0.f, 0.f, 0.f, 0.f}; acc = mfma16(W[t][0], Sb0, acc); acc = mfma16(W[t][1], Sb1, acc);
            const unsigned lo = (unsigned)U[t], hi = (unsigned)(U[t] >> 32);
            vn[t][0] = __builtin_bit_cast(float, lo << 16) - acc[0]; vn[t][1] = __builtin_bit_cast(float, lo & 0xffff0000u) - acc[1];
            vn[t][2] = __builtin_bit_cast(float, hi << 16) - acc[2]; vn[t][3] = __builtin_bit_cast(float, hi & 0xffff0000u) - acc[3]; }
        const bf16x8 vb0 = pack_bf8(vn[0], vn[1]), vb1 = pack_bf8(vn[2], vn[3]);
        { const size_t b0 = ((size_t)((item * 2 + et) * 4 + (q_ >> 1)) * 64 + lp) * 8, b1 = ((size_t)((item * 2 + et) * 4 + 2 + (q_ >> 1)) * 64 + lp) * 8;
          *(GAS bf16x8*)(SPF + b0) = Sb0; *(GAS bf16x8*)(SPF + b1) = Sb1; *(GAS bf16x8*)(VNF + b0) = vb0; *(GAS bf16x8*)(VNF + b1) = vb1; }
#pragma unroll
        for (int t = 0; t < 4; ++t) { f32x4m acc = S[t] * gl; acc = mfma16(KG[t][0], vb0, acc); acc = mfma16(KG[t][1], vb1, acc); S[t] = acc; }
        asm volatile("s_waitcnt lgkmcnt(0)" ::: "memory"); __builtin_amdgcn_s_barrier(); asm volatile("" ::: "memory");
    }
}
__device__ __forceinline__ mx::bf16x8 fragB_perm16(const LAS unsigned char* img, int r0, int sp, int lane) {
    const int q = 2 * (sp & 1) + (lane >> 5), tp = sp >> 1;
    const LAS unsigned char* a = img + (r0 + (lane & 31)) * mx::IROW + (32 * tp + 4 * q) * 2;
    const mx::s16x4 lo = *(const LAS mx::s16x4*)a, hi = *(const LAS mx::s16x4*)(a + 32);
    return (mx::bf16x8){lo[0], lo[1], lo[2], lo[3], hi[0], hi[1], hi[2], hi[3]};
}
__device__ __forceinline__ void dn_out(LAS unsigned char* wl, const bf16* QN, const bf16* KN  , const float* G  ,
                                       const bf16* SPF, const bf16* VNF  , const bf16* Gp, int ldp, const float* norm_g, bf16* Yp, int ldy, int lane) {
    using namespace mx;
    LAS unsigned char* img0 = wl; LAS unsigned char* img1 = wl + IMG_BYTES; LAS float* vg = (LAS float*)(wl + 2 * IMG_BYTES);
    const int hf = lane >> 5;
    vg[lane] = ((const GAS float*)G)[(size_t)lane * 4];
    img_load<64>(img0, QN, 256, lane); img_load<64>(img1, KN, 256, lane);
    LDS_WAIT();
    f32x16 o[2][2];
#pragma unroll
    for (int et = 0; et < 2; ++et)
#pragma unroll
        for (int it = 0; it < 2; ++it) { o[et][it] = zero16();
#pragma unroll
            for (int sp = 0; sp < 4; ++sp) o[et][it] = mfma(*(const GAS bf16x8*)(SPF + ((size_t)(et * 4 + sp) * 64 + lane) * 8), fragB_perm16(img0, 32 * it, sp, lane), o[et][it]);
            const float eg = __expf(vg[32 * it + (lane & 31)]);
#pragma unroll
            for (int r = 0; r < 16; ++r) o[et][it][r] *= eg; }
    f32x16 sc[3];
#pragma unroll
    for (int t = 0; t < 3; ++t) { const int mt = (t == 1) ? 0 : 1, nt = (t == 2) ? 1 : 0; sc[t] = zero16();
#pragma unroll
        for (int s = 0; s < 4; ++s) sc[t] = mfma(frag_row(img0, 32 * mt, 16 * s, lane), frag_row(img1, 32 * nt, 16 * s, lane), sc[t]); }
#pragma unroll
    for (int t = 0; t < 3; ++t) { const int mt = (t == 1) ? 0 : 1, nt = (t == 2) ? 1 : 0; const int j = 32 * nt + (lane & 31); const float gj = vg[j];
#pragma unroll
        for (int g4 = 0; g4 < 4; ++g4) { const int i0 = 32 * mt + 8 * g4 + 4 * hf; const f32x4 gi = *(const LAS f32x4*)(vg + i0);
#pragma unroll
            for (int e = 0; e < 4; ++e) { const int i = i0 + e; const float a = sc[t][4 * g4 + e] * __expf(fminf(gi[e] - gj, 0.f));
                *(LAS bf16*)(img0 + i * IROW + j * 2) = (bf16)f2bf(j <= i ? a : 0.f); } } }
#pragma unroll
    for (int r = 0; r < 16; ++r) { const int i = crow(r, hf), j = 32 + (lane & 31); *(LAS bf16*)(img0 + i * IROW + j * 2) = 0; }
    LDS_WAIT();
#pragma unroll
    for (int et = 0; et < 2; ++et)
#pragma unroll
        for (int it = 0; it < 2; ++it)
#pragma unroll
            for (int sp = 0; sp < 4; ++sp) { if (it == 0 && sp >= 2) continue;
                o[et][it] = mfma(*(const GAS bf16x8*)(VNF + ((size_t)(et * 4 + sp) * 64 + lane) * 8), fragB_perm16(img0, 32 * it, sp, lane), o[et][it]); }
    mx::head_epilogue(o, Gp, ldp, norm_g, Yp, ldy, lane);
}

struct Args { const float* in[23]; float* out; unsigned char* ws; };

__device__ __forceinline__ void p0_transpose_item(const float* W, int K, int N, bf16* WT, LAS float* scr, int item, int lane) {
    const int nblk = (N + 31) / 32, kb = item / nblk, nb = item % nblk, k0 = 64 * kb, n0 = 32 * nb;
#pragma unroll 8
    for (int i = 0; i < 32; ++i) { const int kk = 2 * i + (lane >> 5), n = n0 + (lane & 31); scr[kk * 33 + (lane & 31)] = (n < N) ? W[(size_t)(k0 + kk) * N + n] : 0.f; }
    LDS_WAIT();
    const int c = lane & 7;
#pragma unroll
    for (int j = 0; j < 4; ++j) { const int n = (lane >> 3) + 8 * j; const LAS float* s = scr + (8 * c) * 33 + n;
        v4u o; o.x = pk2(s[0 * 33], s[1 * 33]); o.y = pk2(s[2 * 33], s[3 * 33]); o.z = pk2(s[4 * 33], s[5 * 33]); o.w = pk2(s[6 * 33], s[7 * 33]);
        *(GAS v4u*)(WT + (size_t)(n0 + n) * K + k0 + 8 * c) = o; }
    LDS_WAIT();
}

__device__ __forceinline__ void task_ret(LAS float* scr, const bf16* P, const f32x2v* tab, const float* norm_g, bf16* Y, int h, int lane) {
    const float gamma = 1.f - exp2f(-5.f - (float)h);
    float S[64];
#pragma unroll
    for (int d = 0; d < 64; ++d) S[d] = 0.f;
    const float gn = norm_g[lane];
    const bf16* pr = P + h * 64 + lane;
    bf16 nq = pr[C_RQ], nk = pr[C_RK], nv = pr[C_RV], ng = pr[C_RG]; f32x2v ncs = tab[lane >> 1];
    for (int t = 0; t < L; ++t) {
        const float q = bf2f(nq), k = bf2f(nk), v = bf2f(nv), gate = bf2f(ng); const float cs = ncs.x, sn = ncs.y;
        { const int tn = (t + 1 < L) ? t + 1 : t; const bf16* pn = pr + (size_t)tn * NP; nq = pn[C_RQ]; nk = pn[C_RK]; nv = pn[C_RV]; ng = pn[C_RG]; ncs = tab[tn * 32 + (lane >> 1)]; }
        const float qo = swz_xor<1>(q), ko = swz_xor<1>(k);
        const float qr = (lane & 1) ? (qo * sn + q * cs) : (q * cs - qo * sn);
        const float kr = (lane & 1) ? (ko * sn + k * cs) : (k * cs - ko * sn);
        scr[lane] = qr * 0.125f; scr[64 + lane] = kr;
        LDS_WAIT();
        float o = 0.f;
#pragma unroll
        for (int d = 0; d < 64; ++d) { S[d] = gamma * S[d] + scr[64 + d] * v; o += scr[d] * S[d]; }
        LDS_WAIT();
        const float ms = wave_sum(o * o) * (1.f / 64.f);
        Y[(size_t)t * D + 0 + h * 64 + lane] = (bf16)f2bf(o * rsqrtf(ms + EPS) * gn * siluf_(gate));
    }
}
__device__ __forceinline__ void task_dn(LAS float* scr, const bf16* P, const float* cw  , float a_log, float dt_bias, const float* norm_g, bf16* Y, int h, int lane) {
    float S[64];
#pragma unroll
    for (int d = 0; d < 64; ++d) S[d] = 0.f;
    const float gn = norm_g[lane], A = -expf(a_log);
    float wq[4], wk[4], wv[4];
#pragma unroll
    for (int j = 0; j < 4; ++j) { wq[j] = cw[j * 768 + h * 64 + lane]; wk[j] = cw[j * 768 + 256 + h * 64 + lane]; wv[j] = cw[j * 768 + 512 + h * 64 + lane]; }
    float xq0 = 0.f, xq1 = 0.f, xq2 = 0.f, xk0 = 0.f, xk1 = 0.f, xk2 = 0.f, xv0 = 0.f, xv1 = 0.f, xv2 = 0.f;
    const bf16* pr = P + h * 64 + lane;
    bf16 nq = pr[C_DQKV], nk = pr[C_DQKV + 256], nv = pr[C_DQKV + 512], ng = pr[C_DG], nb = P[C_DBETA + h], na = P[C_DA + h];
    for (int t = 0; t < L; ++t) {
        const float rq = bf2f(nq), rk = bf2f(nk), rv = bf2f(nv), gate = bf2f(ng), bin = bf2f(nb), ain = bf2f(na);
        { const int tn = (t + 1 < L) ? t + 1 : t; const bf16* pn = pr + (size_t)tn * NP; nq = pn[C_DQKV]; nk = pn[C_DQKV + 256]; nv = pn[C_DQKV + 512]; ng = pn[C_DG];
          nb = P[(size_t)tn * NP + C_DBETA + h]; na = P[(size_t)tn * NP + C_DA + h]; }
        float q = siluf_(wq[0] * xq0 + wq[1] * xq1 + wq[2] * xq2 + wq[3] * rq);
        float k = siluf_(wk[0] * xk0 + wk[1] * xk1 + wk[2] * xk2 + wk[3] * rk);
        const float v = siluf_(wv[0] * xv0 + wv[1] * xv1 + wv[2] * xv2 + wv[3] * rv);
        xq0 = xq1; xq1 = xq2; xq2 = rq; xk0 = xk1; xk1 = xk2; xk2 = rk; xv0 = xv1; xv1 = xv2; xv2 = rv;
        q = q * rsqrtf(wave_sum(q * q) + EPS) * 0.125f;
        k = k * rsqrtf(wave_sum(k * k) + EPS);
        const float beta = sigmoidf_(bin);
        const float eg = expf(A * softplusf_(ain + dt_bias));
        scr[lane] = q; scr[64 + lane] = k;
        LDS_WAIT();
        float ks = 0.f;
#pragma unroll
        for (int d = 0; d < 64; ++d) { S[d] *= eg; ks += scr[64 + d] * S[d]; }
        const float vn = beta * (v - ks);
        float o = 0.f;
#pragma unroll
        for (int d = 0; d < 64; ++d) { S[d] += scr[64 + d] * vn; o += scr[d] * S[d]; }
        LDS_WAIT();
        const float ms = wave_sum(o * o) * (1.f / 64.f);
        Y[(size_t)t * D + 256 + h * 64 + lane] = (bf16)f2bf(o * rsqrtf(ms + EPS) * gn * siluf_(gate));
    }
}
__device__ __forceinline__ void task_gla(LAS float* scr, const bf16* P, const float* w_gk  , const float* b_gk, const float* norm_g, bf16* Y, int h, int lane) {
    float S[32];
#pragma unroll
    for (int d = 0; d < 32; ++d) S[d] = 0.f;
    const float gn = norm_g[lane];
    const int dl = lane & 31;
    float wg[16];
#pragma unroll
    for (int r = 0; r < 16; ++r) wg[r] = w_gk[r * 128 + h * 32 + dl];
    const float bg = b_gk[h * 32 + dl];
    const float qs = 0.17677669529663687f;
    for (int t = 0; t < L; ++t) {
        const bf16* pr = P + (size_t)t * NP;
        float z = bg;
#pragma unroll
        for (int r = 0; r < 16; ++r) z += bf2f(pr[C_GCODE + r]) * wg[r];
        const float gk = -softplusf_(-z) * (1.f / 16.f);
        const float qd = bf2f(pr[C_GQ + h * 32 + dl]) * qs, kd = bf2f(pr[C_GK + h * 32 + dl]);
        const float v = bf2f(pr[C_GV + h * 64 + lane]), gate = bf2f(pr[C_GG + h * 64 + lane]);
        if (lane < 32) { scr[dl] = expf(gk); scr[32 + dl] = qd; scr[64 + dl] = kd; }
        LDS_WAIT();
        float o = 0.f;
#pragma unroll
        for (int d = 0; d < 32; ++d) { S[d] = scr[d] * S[d] + scr[64 + d] * v; o += scr[32 + d] * S[d]; }
        LDS_WAIT();
        const float ms = wave_sum(o * o) * (1.f / 64.f);
        Y[(size_t)t * D + 768 + h * 64 + lane] = (bf16)f2bf(o * rsqrtf(ms + EPS) * gn * siluf_(gate));
    }
}
__device__ __forceinline__ void task_s5(bf16* P, const float* coef, const float* c_re, const float* c_im, const float* dd, int g, int lane) {
    const int i = g * 64 + lane;
    const float ar = coef[i], ai = coef[1024 + i];
    float br[16], bi[16], cr[16], ci[16];
#pragma unroll
    for (int h = 0; h < 16; ++h) { br[h] = coef[2048 + i * 16 + h]; bi[h] = coef[2048 + 16384 + i * 16 + h]; cr[h] = c_re[(g * 16 + h) * 64 + lane]; ci[h] = c_im[(g * 16 + h) * 64 + lane]; }
    const float dmy = dd[g * 16 + (lane & 15)];
    float sr = 0.f, si = 0.f;
    for (int t = 0; t < L; ++t) {
        bf16* ur = P + (size_t)t * NP + C_SU + g * 16;
        float u[16];
#pragma unroll
        for (int h = 0; h < 16; ++h) u[h] = bf2f(ur[h]);
        float xr = 0.f, xi = 0.f;
#pragma unroll
        for (int h = 0; h < 16; ++h) { xr += br[h] * u[h]; xi += bi[h] * u[h]; }
        const float nr = ar * sr - ai * si + xr, ni = ar * si + ai * sr + xi;
        sr = nr; si = ni;
        float mine = 0.f, umine = 0.f;
#pragma unroll
        for (int h = 0; h < 16; ++h) { const float tot = wave_sum(cr[h] * sr - ci[h] * si); if ((lane & 15) == h) { mine = tot; umine = u[h]; } }
        if (lane < 16) ur[lane] = (bf16)f2bf(geluf_(mine + dmy * umine));
    }
}

__global__ void __launch_bounds__(NWAVES * 64, 2) hymba_fwd(Args args) {
    extern __shared__ __attribute__((aligned(16))) unsigned char lds[];
    LAS unsigned char* ldsb0 = (LAS unsigned char*)lds;
    volatile LAS unsigned* MISC = (volatile LAS unsigned*)(ldsb0 + MISC_OFF);
    const int tid = threadIdx.x, wave0 = __builtin_amdgcn_readfirstlane(tid >> 6);
    const int G = gridDim.x;
    unsigned char* ws = args.ws;
    gu32* ctl = (gu32*)(ws + WS_CTL);
    for (int u = tid; u < (LDS_BYTES - LDSCTL_OFF) / 4; u += NWAVES * 64) ((LAS unsigned*)(ldsb0 + LDSCTL_OFF))[u] = 0u;
    __syncthreads();
    XcdBarrier bar = xcd_barrier_post((unsigned*)(ctl + CW_BAR), MISC + 8);
#define GRID_BAR() xcd_barrier(bar)
    if (tid == 0) {
#pragma unroll
        for (int k = 0; k < 23; ++k) ((LAS unsigned long long*)(ldsb0 + ARGS_OFF))[k] = (unsigned long long)args.in[k];
        ((LAS unsigned long long*)(ldsb0 + ARGS_OFF))[23] = (unsigned long long)args.out; ((LAS unsigned long long*)(ldsb0 + ARGS_OFF))[24] = (unsigned long long)args.ws;
    }
    __syncthreads();
#define ARGU64(k) ({ const unsigned long long v_ = *(volatile LAS unsigned long long*)(ldsb + ARGS_OFF + 8 * (k)); \
        ((unsigned long long)(unsigned)__builtin_amdgcn_readfirstlane((int)(unsigned)(v_ >> 32)) << 32) | (unsigned)__builtin_amdgcn_readfirstlane((int)(unsigned)v_); })
#define ARGF(k) ((const float*)ARGU64(k))
#define x_in ARGF(0)
#define norm_pre ARGF(1)
#define norm_post ARGF(2)
#define w_in ARGF(3)
#define w_out ARGF(4)
#define ret_norm ARGF(5)
#define dn_conv ARGF(6)
#define dn_a_log ARGF(7)
#define dn_dt_bias ARGF(8)
#define dn_norm ARGF(9)
#define s5_lam_re ARGF(10)
#define s5_lam_im ARGF(11)
#define s5_b_re ARGF(12)
#define s5_b_im ARGF(13)
#define s5_c_re ARGF(14)
#define s5_c_im ARGF(15)
#define s5_d ARGF(16)
#define s5_log_dt ARGF(17)
#define s5_w_glu ARGF(18)
#define s5_b_glu ARGF(19)
#define gla_w_gk ARGF(20)
#define gla_b_gk ARGF(21)
#define gla_norm ARGF(22)
#define X ((float*)ARGU64(23))
#define WSB ((unsigned char*)ARGU64(24))
#define TAB ((f32x2v*)(ws + WS_TAB))
#define COEF ((float*)(ws + WS_COEF))
#define WGLU ((bf16*)(ws + WS_WGLU))
#define WOUT ((bf16*)(ws + WS_WOUT))
#define WIN ((bf16*)(ws + WS_WIN))
#define HY ((bf16*)(ws + WS_HY))
#define P ((bf16*)(ws + WS_P))
#define O32 ((float*)(ws + WS_P))
    const int NGW = G * NWAVES, NGT = G * NWAVES * 64;

#define PHASE_IDS() LAS unsigned char* ldsb_p = ldsb0; asm volatile("" : "+s"(ldsb_p)); LAS unsigned char* const ldsb = ldsb_p; \
        int lane_p, bx_p = blockIdx.x; asm volatile("v_mbcnt_lo_u32_b32 %0, -1, 0\n\tv_mbcnt_hi_u32_b32 %0, -1, %0" : "=v"(lane_p)); asm volatile("" : "+s"(bx_p)); \
        int wave_p = wave0; asm volatile("" : "+s"(wave_p)); const int wave = wave_p; \
        const int lane = lane_p, tid = wave * 64 + lane_p, bx = bx_p, gw = bx * NWAVES + wave, gt = bx * (NWAVES * 64) + tid; unsigned char* const ws = WSB; \
        (void)lane; (void)tid; (void)bx; (void)gw; (void)gt; (void)ws
#define CONVERT_WEIGHTS(wl_) do { \
        LAS float* scr_ = (LAS float*)(ldsb + wave * 16384); const float* wi_ = w_in; const float* wo_ = w_out; const float* wg_ = s5_w_glu; \
        constexpr int I_IN = 16 * 105, I_OUT = 16 * 32, I_GLU = 4 * 8, I_L = I_IN + I_OUT + I_GLU; \
        for (int it_ = gw; it_ < I_L; it_ += NGW) { int r_ = it_; \
            if (r_ < I_IN) { p0_transpose_item(wi_ + (size_t)(wl_) * D * NC, D, NC, WIN, scr_, r_, lane); continue; } r_ -= I_IN; \
            if (r_ < I_OUT) { p0_transpose_item(wo_ + (size_t)(wl_) * D * D, D, D, WOUT, scr_, r_, lane); continue; } r_ -= I_OUT; \
            p0_transpose_item(wg_ + (size_t)(wl_) * 65536, 256, 256, WGLU, scr_, r_, lane); } \
    } while (0)
    {
        PHASE_IDS();
        CONVERT_WEIGHTS(0);
        for (int it = gt; it < 224 * 128; it += NGT) ((GAS v4u*)(WIN + (size_t)3360 * D))[it] = (v4u){0u, 0u, 0u, 0u};
        const float* xin_ = x_in; float* xout_ = X; const float* npre_ = norm_pre;
        for (int m = gw; m < M; m += NGW) {
            const GAS f32x4* xr = (const GAS f32x4*)(xin_ + (size_t)m * D) + lane; GAS f32x4* xo = (GAS f32x4*)(xout_ + (size_t)m * D) + lane;
            f32x4 v[4]; float s = 0.f;
#pragma unroll
            for (int j = 0; j < 4; ++j) { v[j] = xr[64 * j]; xo[64 * j] = v[j]; s += (v[j].x * v[j].x + v[j].y * v[j].y) + (v[j].z * v[j].z + v[j].w * v[j].w); }
            const float rstd = rsqrtf(wave_sum(s) * (1.f / D) + EPS);
            GAS unsigned long long* o8 = (GAS unsigned long long*)(HY + (size_t)m * D) + lane;
#pragma unroll
            for (int j = 0; j < 4; ++j) { const f32x4 gg = ((const GAS f32x4*)npre_)[lane + 64 * j];
                o8[64 * j] = (unsigned long long)pk2(v[j].x * rstd * gg.x, v[j].y * rstd * gg.y) | ((unsigned long long)pk2(v[j].z * rstd * gg.z, v[j].w * rstd * gg.w) << 32); }
        }
        for (int it = gt; it < L * 32; it += NGT) { const int t = it >> 5, i = it & 31; const float inv = powf(10000.f, -(float)(2 * i) / 64.f); float sn, cs; sincosf((float)t * inv, &sn, &cs); TAB[it] = (f32x2v){cs, sn}; }
        {
            const float* ldt_ = s5_log_dt; const float* lre_ = s5_lam_re; const float* lim_ = s5_lam_im; const float* bre_ = s5_b_re; const float* bim_ = s5_b_im;
            const float* cre_ = s5_c_re; const float* cim_ = s5_c_im;
            for (int it = gt; it < DEPTH * 2 * 65536; it += NGT) { const int l = it >> 17, r = it & 131071; ((GAS v4u*)(ws + WS_S5_MAT + (size_t)l * S5_MAT_LAYER + S5_KM_OFF))[r] = (v4u){0u, 0u, 0u, 0u}; }
            for (int it = gt; it < DEPTH * 1024; it += NGT) {
                const int l = it >> 10, i = it & 1023, g = i >> 6, p = i & 63;
                const float dt = expf(ldt_[l * 16 + g]);
                const float lr = lre_[it], li = lim_[it];
                const float mag = expf(lr * dt), ang = li * dt;
                const float ar = mag * cosf(ang), ai = mag * sinf(ang);
                const float den = lr * lr + li * li, nr = ar - 1.f, ni = ai;
                const float cr = (nr * lr + ni * li) / den, ci = (ni * lr - nr * li) / den;
                float* cf = COEF + (size_t)l * COEF_STRIDE;
                cf[i] = ar; cf[1024 + i] = ai;
                float bbr[16], bbi[16];
#pragma unroll
                for (int h = 0; h < 16; ++h) { const float br = bre_[(size_t)it * 16 + h], bi = bim_[(size_t)it * 16 + h];
                    bbr[h] = cr * br - ci * bi; bbi[h] = cr * bi + ci * br; cf[2048 + i * 16 + h] = bbr[h]; cf[2048 + 16384 + i * 16 + h] = bbi[h]; }
                unsigned char* mats = ws + WS_S5_MAT + (size_t)l * S5_MAT_LAYER;
                bf16* em = (bf16*)(mats + S5_EM_OFF) + (size_t)g * 128 * 256; bf16* cm = (bf16*)(mats + S5_CM_OFF) + (size_t)g * 256 * 128;
                float* apow = (float*)(ws + WS_S5_APOW) + ((size_t)(l * 16 + g) * 16 * 64) * 2;
                float pr = 1.f, pi = 0.f;
#pragma unroll 1
                for (int m = 0; m <= 16; ++m) {
                    if (m < 16) {
                        apow[(m * 64 + p) * 2] = pr; apow[(m * 64 + p) * 2 + 1] = pi;
                        const int j = 15 - m;
                        float er[16], ei[16];
#pragma unroll
                        for (int h = 0; h < 16; ++h) { er[h] = pr * bbr[h] - pi * bbi[h]; ei[h] = pr * bbi[h] + pi * bbr[h]; }
                        GAS v4u* d0 = (GAS v4u*)(em + (size_t)p * 256 + j * 16); GAS v4u* d1 = (GAS v4u*)(em + (size_t)(64 + p) * 256 + j * 16);
                        d0[0] = (v4u){pk2(er[0], er[1]), pk2(er[2], er[3]), pk2(er[4], er[5]), pk2(er[6], er[7])}; d0[1] = (v4u){pk2(er[8], er[9]), pk2(er[10], er[11]), pk2(er[12], er[13]), pk2(er[14], er[15])};
                        d1[0] = (v4u){pk2(ei[0], ei[1]), pk2(ei[2], ei[3]), pk2(ei[4], ei[5]), pk2(ei[6], ei[7])}; d1[1] = (v4u){pk2(ei[8], ei[9]), pk2(ei[10], ei[11]), pk2(ei[12], ei[13]), pk2(ei[14], ei[15])};
                    } else { float* a16 = (float*)(ws + WS_S5_APOW + 768 * 1024) + ((size_t)(l * 16 + g) * 64 + p) * 2; a16[0] = pr; a16[1] = pi; }
                    if (m >= 1) { const int ii = m - 1;
#pragma unroll 4
                        for (int h = 0; h < 16; ++h) { const float c_r = cre_[((size_t)(l * 16 + g) * 16 + h) * 64 + p], c_i = cim_[((size_t)(l * 16 + g) * 16 + h) * 64 + p];
                            cm[(size_t)(ii * 16 + h) * 128 + p] = (bf16)f2bf(c_r * pr - c_i * pi); cm[(size_t)(ii * 16 + h) * 128 + 64 + p] = (bf16)f2bf(-(c_r * pi + c_i * pr)); } }
                    const float npr = pr * ar - pi * ai, npi = pr * ai + pi * ar; pr = npr; pi = npi;
                }
            }
        }
    }
    GRID_BAR();
    {
        PHASE_IDS();
        const float* cre_ = s5_c_re; const float* cim_ = s5_c_im; const float* dd_ = s5_d;
        for (int it = gt; it < DEPTH * 16 * 16 * 256; it += NGT) {
            const int l = it >> 16, g = (it >> 12) & 15, d = (it >> 8) & 15, h = (it >> 4) & 15, hp = it & 15;
            const float* cf = COEF + (size_t)l * COEF_STRIDE;
            const float* apow = (const float*)(ws + WS_S5_APOW) + ((size_t)((l * 16 + g) * 16 + d) * 64) * 2;
            const float* crp = cre_ + ((size_t)(l * 16 + g) * 16 + h) * 64; const float* cip = cim_ + ((size_t)(l * 16 + g) * 16 + h) * 64;
            float acc = 0.f;
#pragma unroll 4
            for (int p = 0; p < 64; ++p) { const float pr = apow[2 * p], pi = apow[2 * p + 1], br = cf[2048 + (g * 64 + p) * 16 + hp], bi = cf[2048 + 16384 + (g * 64 + p) * 16 + hp];
                const float zr = pr * br - pi * bi, zi = pr * bi + pi * br;
                acc += crp[p] * zr - cip[p] * zi; }
            if (d == 0 && h == hp) acc += dd_[(l * 16 + g) * 16 + h];
            bf16* km = (bf16*)(ws + WS_S5_MAT + (size_t)l * S5_MAT_LAYER + S5_KM_OFF) + (size_t)g * 256 * 256;
            const bf16 v = (bf16)f2bf(acc);
            for (int j = 0; j + d < 16; ++j) km[(size_t)((j + d) * 16 + h) * 256 + j * 16 + hp] = v;
        }
    }
    GRID_BAR();

#pragma nounroll
    for (int l = 0; l < DEPTH; ++l) {
        {
            PHASE_IDS();
            pg8::Gemm g{HY, WIN, M, NP, D, D, D}; pg8::StaticOrder S; S.init(M, NP, G, bx);
            pg8::EpiStoreBf16 E{P, NP};
            pg8::gemm_phase<pg8::EpiStoreBf16, pg8::StaticOrder, true, true, D, D, D>(ldsb, g, S, E, tid);
        }
        GRID_BAR();
        {
            PHASE_IDS();
            LAS unsigned char* wl = ldsb + wave * mx::WLDS;
            const DnBufs dnb{(bf16*)(ws + WS_DN_WF), (bf16*)(ws + WS_DN_KGF), (bf16*)(ws + WS_DN_UF), (bf16*)(ws + WS_DN_QN), (bf16*)(ws + WS_DN_KN), (float*)(ws + WS_DN_G), (float*)(ws + WS_DN_GL)};
            for (int it = gw; it < 3584; it += NGW) {
                int lane_i = lane_p; asm volatile("" : "+v"(lane_i)); const int lane = lane_i;
                if (it < 3072) {
                    const int ii = it & 1023, bh = ii >> 7, n = ii & 127, b = bh >> 2, h = bh & 3;
                    const size_t t0 = (size_t)(b * L + n * 64);
                    bf16* Pt = P + t0 * NP;
                    if (it < 1024) dn_A(wl, Pt, t0, n, h, ii, dn_conv + (size_t)l * 4 * 768, dn_a_log[l * 4 + h], dn_dt_bias[l * 4 + h], dnb, lane);
                    else if (it < 2048) ret_A(wl, Pt, TAB, n * 64, h, (float*)(ws + WS_RET_KV) + (size_t)ii * 4096, lane);
                    else gla_A(wl, Pt, gla_w_gk + (size_t)l * 16 * 128, gla_b_gk + l * 128, h, (float*)(ws + WS_GLA_KV) + (size_t)ii * 2048, (float*)(ws + WS_GLA_DEC) + (size_t)ii * 32, lane);
                } else { const int i5 = it - 3072; s5_item<false>(P + C_SU, ws + WS_S5_MAT + (size_t)l * S5_MAT_LAYER, (float*)(ws + WS_S5_E), nullptr, i5 & 15, i5 >> 4, lane); }
            }
        }
        GRID_BAR();
        {
            PHASE_IDS();
            if (bx >= 96 && bx < 128) { const int b = (bx - 96) >> 4, g = (bx - 96) & 15;
                s5_scan_block((LAS float*)ldsb, (const float*)(ws + WS_S5_E) + (size_t)b * 512 * 2048, (bf16*)(ws + WS_S5_SP) + (size_t)b * 512 * 2048,
                              (const float*)(ws + WS_S5_APOW + 768 * 1024) + ((size_t)(l * 16 + g) * 64) * 2, g, tid); }
            else if (bx >= 128 && bx < 136) dn_scan_block(ldsb, (const bf16*)(ws + WS_DN_WF), (const bf16*)(ws + WS_DN_KGF), (const bf16*)(ws + WS_DN_UF), (const float*)(ws + WS_DN_GL),
                                                        (bf16*)(ws + WS_DN_SPF), (bf16*)(ws + WS_DN_VNF), bx - 128, wave, lane);
            else if (wave == 0) {
                if (bx < 64) { const int bh = bx >> 3, sub = bx & 7; const float g64 = exp2f(64.f * log2f(1.f - exp2f(-5.f - (float)(bh & 3))));
                    la_scan<2>((const float*)(ws + WS_RET_KV) + (size_t)bh * 128 * 4096, (bf16*)(ws + WS_RET_RP) + (size_t)bh * 128 * 4096, nullptr, g64, sub, lane); }
                else if (bx < 96) { const int bh = (bx - 64) >> 2, sub = (bx - 64) & 3;
                    la_scan<1>((const float*)(ws + WS_GLA_KV) + (size_t)bh * 128 * 2048, (bf16*)(ws + WS_GLA_RP) + (size_t)bh * 128 * 2048, (const float*)(ws + WS_GLA_DEC) + (size_t)bh * 128 * 32, 0.f, sub, lane); }
            }
        }
        GRID_BAR();
        {
            PHASE_IDS();
            LAS unsigned char* wl = ldsb + wave * mx::WLDS;
            for (int it = gw; it < 3584; it += NGW) {
                int lane_i = lane_p; asm volatile("" : "+v"(lane_i)); const int lane = lane_i;
                if (it < 3072) {
                    const int ii = it & 1023, bh = ii >> 7, n = ii & 127, b = bh >> 2, h = bh & 3;
                    const size_t t0 = (size_t)(b * L + n * 64);
                    const bf16* Pt = P + t0 * NP;
                    if (it < 1024) dn_out(wl, (const bf16*)(ws + WS_DN_QN) + t0 * 256 + h * 64, (const bf16*)(ws + WS_DN_KN) + t0 * 256 + h * 64, (const float*)(ws + WS_DN_G) + t0 * 4 + h,
                                          (const bf16*)(ws + WS_DN_SPF) + (size_t)ii * 4096, (const bf16*)(ws + WS_DN_VNF) + (size_t)ii * 4096, Pt + C_DG + h * 64, NP, dn_norm + l * 64, HY + t0 * D + 256 + h * 64, D, lane);
                    else if (it < 2048) mx::la_out<64>(wl, Pt + C_RQ + h * 64, Pt + C_RK + h * 64, NP, Pt + C_RV + h * 64, Pt + C_RG + h * 64, NP,
                                              (const bf16*)(ws + WS_RET_RP) + (size_t)ii * 4096, ret_norm + l * 64, HY + t0 * D + 0 + h * 64, D, lane);
                    else mx::la_out<32>(wl, Pt + C_GQ + h * 32, Pt + C_GK + h * 32, NP, Pt + C_GV + h * 64, Pt + C_GG + h * 64, NP,
                                    (const bf16*)(ws + WS_GLA_RP) + (size_t)ii * 2048, gla_norm + l * 64, HY + t0 * D + 768 + h * 64, D, lane);
                } else { const int i5 = it - 3072; s5_item<true>(P + C_SU, ws + WS_S5_MAT + (size_t)l * S5_MAT_LAYER, nullptr, (const bf16*)(ws + WS_S5_SP), i5 & 15, i5 >> 4, lane); }
            }
        }
        GRID_BAR();
        {
            PHASE_IDS();
            pg8::Gemm g{P + C_SU, WGLU, M, 256, 256, NP, 256}; pg8::StaticOrder S; S.init(M, 256, G, bx);
            pg8::EpiGlu E{P + C_SU, P + C_SG, NP, s5_b_glu + l * 256, HY + 512, D};
            pg8::gemm_phase<pg8::EpiGlu, pg8::StaticOrder, true, true, 256, NP, 256>(ldsb, g, S, E, tid);
        }
        GRID_BAR();
        {
            PHASE_IDS();
            pg8::Gemm g{HY, WOUT, M, D, D, D, D}; pg8::StaticOrder S; S.init(M, D, G, bx);
            pg8::EpiStoreF32 E{O32, D};
            pg8::gemm_phase<pg8::EpiStoreF32, pg8::StaticOrder, true, true, D, D, D>(ldsb, g, S, E, tid);
        }
        GRID_BAR();
        {
            PHASE_IDS();
            if (l + 1 < DEPTH) CONVERT_WEIGHTS(l + 1);
            float* xout_ = X; const float* npost_ = norm_post + l * D; const float* npre_ = norm_pre + (l + 1 < DEPTH ? l + 1 : l) * D;
            for (int m = gw; m < M; m += NGW) {
                const GAS f32x4* orow = (const GAS f32x4*)(O32 + (size_t)m * D) + lane; GAS f32x4* xr = (GAS f32x4*)(xout_ + (size_t)m * D) + lane;
                f32x4 o[4], xv[4]; float s = 0.f;
#pragma unroll
                for (int j = 0; j < 4; ++j) { o[j] = orow[64 * j]; xv[j] = xr[64 * j]; s += (o[j].x * o[j].x + o[j].y * o[j].y) + (o[j].z * o[j].z + o[j].w * o[j].w); }
                const float rstd = rsqrtf(wave_sum(s) * (1.f / D) + EPS);
                float s2 = 0.f;
#pragma unroll
                for (int j = 0; j < 4; ++j) { const f32x4 gg = ((const GAS f32x4*)npost_)[lane + 64 * j];
                    xv[j].x += o[j].x * rstd * gg.x; xv[j].y += o[j].y * rstd * gg.y; xv[j].z += o[j].z * rstd * gg.z; xv[j].w += o[j].w * rstd * gg.w;
                    xr[64 * j] = xv[j]; s2 += (xv[j].x * xv[j].x + xv[j].y * xv[j].y) + (xv[j].z * xv[j].z + xv[j].w * xv[j].w); }
                if (l + 1 < DEPTH) {
                    const float r2 = rsqrtf(wave_sum(s2) * (1.f / D) + EPS);
                    GAS unsigned long long* o8 = (GAS unsigned long long*)(HY + (size_t)m * D) + lane;
#pragma unroll
                    for (int j = 0; j < 4; ++j) { const f32x4 gg = ((const GAS f32x4*)npre_)[lane + 64 * j];
                        o8[64 * j] = (unsigned long long)pk2(xv[j].x * r2 * gg.x, xv[j].y * r2 * gg.y) | ((unsigned long long)pk2(xv[j].z * r2 * gg.z, xv[j].w * r2 * gg.w) << 32); }
                }
            }
        }
        if (l + 1 < DEPTH) GRID_BAR();
    }
}

extern "C" void kernel_launch(void* const* d_in, const int* in_sizes, int n_in, void* d_out, int out_size, void* d_ws, size_t ws_size, hipStream_t stream) {
    static int grid = 0;
    if (grid == 0) {
        if (n_in != 23 || out_size != M * D || ws_size < WS_END) { fprintf(stderr, "kernel_launch: unexpected shapes (n_in %d out %d ws %zu)\n", n_in, out_size, ws_size); grid = -1; return; }
        int dev = 0, cus = 0, per_cu = 0;
        if (hipGetDevice(&dev) != hipSuccess || hipDeviceGetAttribute(&cus, hipDeviceAttributeMultiprocessorCount, dev) != hipSuccess) { grid = -1; return; }
        if (hipFuncSetAttribute((const void*)hymba_fwd, hipFuncAttributeMaxDynamicSharedMemorySize, LDS_BYTES) != hipSuccess) { fprintf(stderr, "kernel_launch: hipFuncSetAttribute failed\n"); grid = -1; return; }
        if (hipOccupancyMaxActiveBlocksPerMultiprocessor(&per_cu, (const void*)hymba_fwd, NWAVES * 64, LDS_BYTES) != hipSuccess || per_cu < 1) { fprintf(stderr, "kernel_launch: occupancy query says %d blocks/CU\n", per_cu); grid = -1; return; }
        grid = cus;
    }
    if (grid < 0) return;
    (void)hipMemsetAsync((char*)d_ws + WS_CTL, 0, CTL_ZERO_BYTES, stream);
    Args a{};
    for (int i = 0; i < 23; ++i) a.in[i] = (const float*)d_in[i];
    a.out = (float*)d_out; a.ws = (unsigned char*)d_ws;
    void* kargs[] = {&a};
    const hipError_t e = hipLaunchCooperativeKernel((const void*)hymba_fwd, dim3(grid), dim3(NWAVES * 64), kargs, LDS_BYTES, stream);
    if (e != hipSuccess) fprintf(stderr, "cooperative launch failed: %s (grid %d)\n", hipGetErrorString(e), grid);
}
```
